# Optimizing an MI355X kernel written in HIP

```python
import jax, jax.numpy as jnp
from jax import lax
import numpy as np

D_MODEL = 1024
BATCH = 2
SEQ = 16384
DEPTH = 2

N_A_LAYERS = DEPTH // 2
N_B_LAYERS = DEPTH - N_A_LAYERS

LRU_WIDTH = D_MODEL
LRU_BLOCKS = 8
LRU_BLOCK_W = LRU_WIDTH // LRU_BLOCKS
CONV_WIDTH = 4
LRU_C = 8.0

HEAD_DIM = 128
Q_HEADS = D_MODEL // HEAD_DIM
KV_HEADS = 2
Q_PER_KV = Q_HEADS // KV_HEADS
DILATION_GROUPS = ((128, 1), (512, 4), (2048, 16))
N_GROUPS = len(DILATION_GROUPS)
ATT_BLOCK = 128
ROPE_DIM = HEAD_DIM // 4
ROPE_THETA = 500000.0

FFN_HIDDEN = -(-8 * D_MODEL // (3 * 256)) * 256
EPS = 1e-6
NEG_INF = -1e30

kernel_name = "yoco_rglru_dilated_swa_hybrid"


def rms_norm(x, g):
    x32 = x.astype(jnp.float32)
    y = x32 * lax.rsqrt(jnp.mean(x32 * x32, axis=-1, keepdims=True) + EPS)
    return (y * g.astype(jnp.float32)).astype(x.dtype)


def rope_tables(positions):
    inv_freq = ROPE_THETA ** (-jnp.arange(0, ROPE_DIM, 2, dtype=jnp.float32) / ROPE_DIM)
    ang = positions.astype(jnp.float32)[..., None] * inv_freq
    return jnp.cos(ang), jnp.sin(ang)


def apply_partial_rope(x, cos, sin):
    extra = x.ndim - 3
    shp = cos.shape[:2] + (1,) * extra + cos.shape[-1:]
    c, s = cos.reshape(shp), sin.reshape(shp)
    half = ROPE_DIM // 2
    xr = x[..., :ROPE_DIM].astype(jnp.float32)
    x1, x2 = xr[..., :half], xr[..., half:]
    rot = jnp.concatenate([x1 * c - x2 * s, x2 * c + x1 * s], axis=-1)
    return jnp.concatenate([rot.astype(x.dtype), x[..., ROPE_DIM:]], axis=-1)


def causal_depthwise_conv(x, w, b):
    y = lax.conv_general_dilated(
        x, w[:, None, :].astype(x.dtype), window_strides=(1,),
        padding=((CONV_WIDTH - 1, 0),), dimension_numbers=('NWC', 'WIO', 'NWC'),
        feature_group_count=x.shape[-1])
    return y + b.astype(x.dtype)


def rg_lru(x, w_a, b_a, w_x, b_x, lam):
    B, S, C = x.shape
    x32 = x.astype(jnp.float32)
    xb = x32.reshape(B, S, LRU_BLOCKS, LRU_BLOCK_W)
    r_gate = jax.nn.sigmoid(jnp.einsum('bshi,hij->bshj', xb, w_a.astype(jnp.float32)).reshape(B, S, C) + b_a.astype(jnp.float32))
    i_gate = jax.nn.sigmoid(jnp.einsum('bshi,hij->bshj', xb, w_x.astype(jnp.float32)).reshape(B, S, C) + b_x.astype(jnp.float32))
    log_a = -LRU_C * r_gate * jax.nn.softplus(-lam.astype(jnp.float32))
    a = jnp.exp(log_a)
    u = jnp.sqrt(-jnp.expm1(2.0 * log_a)) * (i_gate * x32)

    def combine(left, right):
        a1, b1 = left
        a2, b2 = right
        return a1 * a2, a2 * b1 + b2

    _, h = lax.associative_scan(combine, (a, u), axis=1)
    return h.astype(x.dtype)


def recurrent_mixer(h, w_in, conv_w, conv_b, ga_w, ga_b, gx_w, gx_b, lam, w_out):
    proj = h @ w_in
    y_branch, x_branch = jnp.split(proj, 2, axis=-1)
    gate = jax.nn.gelu(y_branch, approximate=True)
    xc = causal_depthwise_conv(x_branch, conv_w, conv_b)
    hr = rg_lru(xc, ga_w, ga_b, gx_w, gx_b, lam)
    return (gate * hr) @ w_out


def swiglu(h, w_in, w_out):
    g, u = jnp.split(h @ w_in, 2, axis=-1)
    return (jax.nn.silu(g) * u) @ w_out


def shared_kv(h, kv_norm, w_kv, k_norm, cos, sin):
    B, S, _ = h.shape
    hn = rms_norm(h, kv_norm)
    kv = (hn @ w_kv).reshape(B, S, N_GROUPS, 2, KV_HEADS, HEAD_DIM)
    k, v = kv[:, :, :, 0], kv[:, :, :, 1]
    k = rms_norm(k, k_norm[:, None, :])
    k = apply_partial_rope(k, cos, sin)
    return k, v


def dilated_window_attention(q, k, v, window, dilation):
    B, S = q.shape[:2]
    n_keys = window // dilation
    span = dilation * ATT_BLOCK
    S_pad = -(-S // span) * span
    L = S_pad // dilation
    nb = L // ATT_BLOCK
    pad = S_pad - S

    def to_phase(t):
        t = jnp.pad(t, [(0, 0), (0, pad)] + [(0, 0)] * (t.ndim - 2))
        t = t.reshape((B, L, dilation) + t.shape[2:])
        t = jnp.moveaxis(t, 2, 1)
        return t.reshape((B, dilation, nb, ATT_BLOCK) + t.shape[3:])

    def with_prev(t):
        prev = jnp.pad(t, [(0, 0), (0, 0), (1, 0)] + [(0, 0)] * (t.ndim - 3))[:, :, :-1]
        return jnp.concatenate([prev, t], axis=3)

    qp = to_phase(q)
    kb = with_prev(to_phase(k))
    vb = with_prev(to_phase(v))
    s = jnp.einsum('bpnqhgd,bpnkhd->bpnhgqk', qp, kb).astype(jnp.float32) * (HEAD_DIM ** -0.5)
    q_idx = jnp.arange(ATT_BLOCK)[:, None] + ATT_BLOCK
    k_idx = jnp.arange(2 * ATT_BLOCK)[None, :]
    dist = q_idx - k_idx
    band = (dist >= 0) & (dist <= n_keys)
    has_prev = (jnp.arange(nb)[:, None, None] > 0) | (k_idx >= ATT_BLOCK)[None]
    mask = band[None] & has_prev
    s = jnp.where(mask[None, None, :, None, None], s, NEG_INF)
    m = jnp.max(s, axis=-1, keepdims=True)
    p = jnp.exp(s - m)
    den = jnp.sum(p, axis=-1, keepdims=True)
    o = jnp.einsum('bpnhgqk,bpnkhd->bpnqhgd', (p / den).astype(v.dtype), vb)
    lse = jnp.moveaxis((m + jnp.log(den))[..., 0], -1, 3)

    def from_phase(t):
        t = t.reshape((B, dilation, L) + t.shape[4:])
        t = jnp.moveaxis(t, 1, 2).reshape((B, S_pad) + t.shape[3:])
        return t[:, :S]

    return from_phase(o), from_phase(lse)


def dilated_attention_mixer(h, w_q, q_norm, w_o, k, v, cos, sin):
    B, S, _ = h.shape
    q = (h @ w_q).reshape(B, S, N_GROUPS, Q_HEADS, HEAD_DIM)
    q = rms_norm(q, q_norm[:, None, :])
    q = apply_partial_rope(q, cos, sin)
    q = q.reshape(B, S, N_GROUPS, KV_HEADS, Q_PER_KV, HEAD_DIM)
    outs, lses = [], []
    for g, (window, dilation) in enumerate(DILATION_GROUPS):
        o, l = dilated_window_attention(q[:, :, g], k[:, :, g], v[:, :, g], window, dilation)
        outs.append(o)
        lses.append(l)
    wts = jax.nn.softmax(jnp.stack(lses, axis=0), axis=0)
    o = jnp.sum(wts[..., None] * jnp.stack(outs, axis=0).astype(jnp.float32), axis=0).astype(h.dtype)
    return o.reshape(B, S, Q_HEADS * HEAD_DIM) @ w_o


def setup_inputs(seed: int = 0) -> dict:
    key = jax.random.key(seed)
    ks = jax.random.split(key, 32)

    def nrm(k, shape, fan_in):
        return jax.random.normal(k, shape, jnp.float32) * (fan_in ** -0.5)

    def gain(k, shape):
        return 1.0 + 0.05 * jax.random.normal(k, shape, jnp.float32)

    def bias(k, shape):
        return 0.01 * jax.random.normal(k, shape, jnp.float32)

    nA, nB = N_A_LAYERS, N_B_LAYERS
    a8 = jax.random.uniform(ks[9], (nA, LRU_WIDTH), jnp.float32, 0.9, 0.999)
    a0 = a8 ** (1.0 / LRU_C)
    lam = jnp.log(a0) - jnp.log1p(-a0)
    return {
        "x": jax.random.normal(ks[0], (BATCH, SEQ, D_MODEL), jnp.float32),
        "positions": jnp.broadcast_to(jnp.arange(SEQ, dtype=jnp.int32)[None, :], (BATCH, SEQ)),
        "a_norm": gain(ks[1], (nA, D_MODEL)),
        "a_w_in": nrm(ks[2], (nA, D_MODEL, 2 * LRU_WIDTH), D_MODEL),
        "a_conv_w": nrm(ks[3], (nA, CONV_WIDTH, LRU_WIDTH), CONV_WIDTH),
        "a_conv_b": bias(ks[4], (nA, LRU_WIDTH)),
        "a_gate_a_w": nrm(ks[5], (nA, LRU_BLOCKS, LRU_BLOCK_W, LRU_BLOCK_W), LRU_BLOCK_W),
        "a_gate_a_b": bias(ks[6], (nA, LRU_WIDTH)),
        "a_gate_x_w": nrm(ks[7], (nA, LRU_BLOCKS, LRU_BLOCK_W, LRU_BLOCK_W), LRU_BLOCK_W),
        "a_gate_x_b": bias(ks[8], (nA, LRU_WIDTH)),
        "a_lambda": lam,
        "a_w_out": nrm(ks[10], (nA, LRU_WIDTH, D_MODEL), LRU_WIDTH),
        "a_ffn_norm": gain(ks[11], (nA, D_MODEL)),
        "a_ffn_w_in": nrm(ks[12], (nA, D_MODEL, 2 * FFN_HIDDEN), D_MODEL),
        "a_ffn_w_out": nrm(ks[13], (nA, FFN_HIDDEN, D_MODEL), FFN_HIDDEN),
        "kv_norm": gain(ks[14], (D_MODEL,)),
        "w_kv": nrm(ks[15], (D_MODEL, N_GROUPS * 2 * KV_HEADS * HEAD_DIM), D_MODEL),
        "k_norm": gain(ks[16], (N_GROUPS, HEAD_DIM)),
        "b_norm": gain(ks[17], (nB, D_MODEL)),
        "b_w_q": nrm(ks[18], (nB, D_MODEL, N_GROUPS * Q_HEADS * HEAD_DIM), D_MODEL),
        "b_q_norm": gain(ks[19], (nB, N_GROUPS, HEAD_DIM)),
        "b_w_o": nrm(ks[20], (nB, Q_HEADS * HEAD_DIM, D_MODEL), Q_HEADS * HEAD_DIM),
        "b_ffn_norm": gain(ks[21], (nB, D_MODEL)),
        "b_ffn_w_in": nrm(ks[22], (nB, D_MODEL, 2 * FFN_HIDDEN), D_MODEL),
        "b_ffn_w_out": nrm(ks[23], (nB, FFN_HIDDEN, D_MODEL), FFN_HIDDEN),
    }


def reference(x, positions, a_norm, a_w_in, a_conv_w, a_conv_b, a_gate_a_w, a_gate_a_b,
              a_gate_x_w, a_gate_x_b, a_lambda, a_w_out, a_ffn_norm, a_ffn_w_in, a_ffn_w_out,
              kv_norm, w_kv, k_norm, b_norm, b_w_q, b_q_norm, b_w_o, b_ffn_norm, b_ffn_w_in,
              b_ffn_w_out):
    cos, sin = rope_tables(positions)
    h = x
    k = v = None
    for layer in range(DEPTH):
        if layer < N_A_LAYERS:
            i = layer
            h = h + recurrent_mixer(rms_norm(h, a_norm[i]), a_w_in[i], a_conv_w[i], a_conv_b[i],
                                    a_gate_a_w[i], a_gate_a_b[i], a_gate_x_w[i], a_gate_x_b[i],
                                    a_lambda[i], a_w_out[i])
            h = h + swiglu(rms_norm(h, a_ffn_norm[i]), a_ffn_w_in[i], a_ffn_w_out[i])
        else:
            if layer == N_A_LAYERS:
                k, v = shared_kv(h, kv_norm, w_kv, k_norm, cos, sin)
            j = layer - N_A_LAYERS
            h = h + dilated_attention_mixer(rms_norm(h, b_norm[j]), b_w_q[j], b_q_norm[j], b_w_o[j],
                                            k, v, cos, sin)
            h = h + swiglu(rms_norm(h, b_ffn_norm[j]), b_ffn_w_in[j], b_ffn_w_out[j])
    return h
```

```cpp
#include <hip/hip_runtime.h>
#include <hip/hip_cooperative_groups.h>
#include <cstdio>
#include <cstdint>
#include <cmath>
namespace cg = cooperative_groups;
namespace pg8 {
#define PG8_LAS __attribute__((address_space(3)))
typedef unsigned short bf16_t;
typedef short bf16x8 __attribute__((ext_vector_type(8)));
typedef float f32x4 __attribute__((ext_vector_type(4)));
typedef unsigned u32x4 __attribute__((ext_vector_type(4)));
constexpr int BM = 256, BK = 64, HALF = 128, HTB = HALF * BK * 2  , STAGE_BYTES = 8 * HTB, NXCD = 8, WGM = 8;

__host__ __device__ __forceinline__ int lds_byte(int r, int c) { const int st = (r >> 4) * 2 + (c >> 5), rr = r & 15, cc = c & 31, ob = rr * 64 + cc * 2; return st * 1024 + (ob ^ (((ob >> 9) & 1) << 5)); }
__host__ __device__ __forceinline__ void stage_rc(int b, int& R, int& C) { const int st = b / 1024, sb = b % 1024, swz = sb ^ (((sb >> 9) & 1) << 5); R = (st >> 1) * 16 + swz / 64; C = (st & 1) * 32 + (swz % 64) / 2; }
__host__ __device__ __forceinline__ int perm32(int rho) { const int n = rho >> 4, i = rho & 15; return 8 * (i >> 2) + 4 * n + (i & 3); }

struct Unit { int pm, pn; };
struct Gemm { const bf16_t* A; const bf16_t* Bt; int M, N, K; };

struct StaticOrder {
    int nM, nN, nwg, G, c, wgm;
    __host__ __device__ void init(int M, int N, int G_, int c_, int wgm_ = 1) { nM = M / BM; nN = N / BM; nwg = nM * nN; G = G_; c = c_; wgm = wgm_; }
    __host__ __device__ bool next(int i, Unit& u) const {
        const long L = (long)i * G + c; if (L >= nwg) return false;
        int wgid = (int)L; { const int q = nwg / NXCD, r = nwg % NXCD, xcd = wgid % NXCD, off = wgid / NXCD; wgid = (xcd < r ? xcd * (q + 1) : r * (q + 1) + (xcd - r) * q) + off; }
        const int nig = wgm * nN, gid = wgid / nig, fm = gid * wgm, gsz = (nM - fm) < wgm ? (nM - fm) : wgm;
        u.pm = fm + ((wgid % nig) % gsz); u.pn = (wgid % nig) / gsz; return true;
    }
    __device__ __forceinline__ void a_ready(const Unit&) const {}
    __device__ __forceinline__ void done(const Unit&) const {}
};

__device__ __forceinline__ unsigned cvt_pk_bf16(float lo, float hi) { unsigned r; asm volatile("v_cvt_pk_bf16_f32 %0, %1, %2" : "=v"(r) : "v"(lo), "v"(hi)); return r; }
typedef float f32x2 __attribute__((ext_vector_type(2)));

typedef unsigned u32x2 __attribute__((ext_vector_type(2)));
__device__ __forceinline__ float fast_sigmoid(float x) { return __builtin_amdgcn_rcpf(1.0f + __builtin_amdgcn_exp2f(-1.44269504089f * x)); }
__device__ __forceinline__ float gelu_tanh(float v) {
    const float t = v * (1.0f + 0.044715f * v * v);
    return v * __builtin_amdgcn_rcpf(1.0f + __builtin_amdgcn_exp2f(-2.302208198f * t));
}
__device__ __forceinline__ float ld_coherent(const float* p) { return __hip_atomic_load(p, __ATOMIC_RELAXED, __HIP_MEMORY_SCOPE_AGENT); }

struct EpiRecIn {
    static constexpr bool PERM = true, AFTER_DRAIN = false;
    bf16_t* Gt; bf16_t* XB;
    __device__ __forceinline__ void operator()(const f32x4 (&acc)[2][2][4][2], const Unit& u, int wr, int wc, int fr, int fq) const {
        const bool is_gate = u.pn < 4; bf16_t* base = is_gate ? Gt : XB;
        const int row0 = u.pm * BM + wr * 64 + fr, col0 = (u.pn & 3) * BM + wc * 32 + 8 * fq;
#pragma unroll
        for (int ai = 0; ai < 2; ++ai)
#pragma unroll
            for (int m = 0; m < 4; ++m) { bf16_t* rowp = base + (size_t)(row0 + ai * HALF + m * 16) * 1024 + col0;
#pragma unroll
                for (int bj = 0; bj < 2; ++bj) { f32x4 v0 = acc[ai][bj][m][0], v1 = acc[ai][bj][m][1];
                    if (is_gate) {
#pragma unroll
                        for (int e = 0; e < 4; ++e) { v0[e] = gelu_tanh(v0[e]); v1[e] = gelu_tanh(v1[e]); } }
                    u32x4 w; w.x = cvt_pk_bf16(v0[0], v0[1]); w.y = cvt_pk_bf16(v0[2], v0[3]); w.z = cvt_pk_bf16(v1[0], v1[1]); w.w = cvt_pk_bf16(v1[2], v1[3]);
                    *(u32x4*)(rowp + bj * HALF) = w; } }
    }
};
__device__ __forceinline__ float sum_fq(float v) {
    { const auto r = __builtin_amdgcn_permlane16_swap(__float_as_uint(v), __float_as_uint(v), false, false); v = __uint_as_float(r[0]) + __uint_as_float(r[1]); }
    { const auto r = __builtin_amdgcn_permlane32_swap(__float_as_uint(v), __float_as_uint(v), false, false); v = __uint_as_float(r[0]) + __uint_as_float(r[1]); }
    return v;
}
template <bool BASE_F32, bool OUT_F32> struct EpiRes {
    static constexpr bool PERM = true, AFTER_DRAIN = false;
    const void* base; void* out; float* rowss;
    __device__ __forceinline__ void finish(const f32x4 b0, const f32x4 b1, const f32x4 a0, const f32x4 a1, size_t off, float& ss) const {
        const f32x4 o0 = b0 + a0, o1 = b1 + a1;
        if (OUT_F32) { *(f32x4*)((float*)out + off) = o0; *(f32x4*)((float*)out + off + 4) = o1; }
        else { u32x4 w; w.x = cvt_pk_bf16(o0[0], o0[1]); w.y = cvt_pk_bf16(o0[2], o0[3]); w.z = cvt_pk_bf16(o1[0], o1[1]); w.w = cvt_pk_bf16(o1[2], o1[3]); *(u32x4*)((bf16_t*)out + off) = w; }
        ss += (o0[0] * o0[0] + o0[1] * o0[1]) + (o0[2] * o0[2] + o0[3] * o0[3]) + (o1[0] * o1[0] + o1[1] * o1[1]) + (o1[2] * o1[2] + o1[3] * o1[3]);
    }
    __device__ __forceinline__ void operator()(const f32x4 (&acc)[2][2][4][2], const Unit& u, int wr, int wc, int fr, int fq) const {
        asm volatile("" : "+v"(fr), "+v"(fq));
        const int row0 = u.pm * BM + wr * 64 + fr, col0 = u.pn * BM + wc * 32 + 8 * fq;
        if constexpr (!BASE_F32) {
            u32x4 bw[2][4][2];
#pragma unroll
            for (int ai = 0; ai < 2; ++ai)
#pragma unroll
                for (int m = 0; m < 4; ++m)
#pragma unroll
                    for (int bj = 0; bj < 2; ++bj) bw[ai][m][bj] = *(const u32x4*)((const bf16_t*)base + (size_t)(row0 + ai * HALF + m * 16) * 1024 + col0 + bj * HALF);
#pragma unroll
            for (int ai = 0; ai < 2; ++ai)
#pragma unroll
                for (int m = 0; m < 4; ++m) { const int r = row0 + ai * HALF + m * 16; const size_t off = (size_t)r * 1024 + col0; float ss = 0.f;
#pragma unroll
                    for (int bj = 0; bj < 2; ++bj) { const u32x4 w = bw[ai][m][bj];
                        const f32x4 b0 = (f32x4){__uint_as_float(w.x << 16), __uint_as_float(w.x & 0xffff0000u), __uint_as_float(w.y << 16), __uint_as_float(w.y & 0xffff0000u)};
                        const f32x4 b1 = (f32x4){__uint_as_float(w.z << 16), __uint_as_float(w.z & 0xffff0000u), __uint_as_float(w.w << 16), __uint_as_float(w.w & 0xffff0000u)};
                        finish(b0, b1, acc[ai][bj][m][0], acc[ai][bj][m][1], off + bj * HALF, ss); }
                    if (rowss) { ss = sum_fq(ss); if (fq == 0) __hip_atomic_fetch_add(rowss + r, ss, __ATOMIC_RELAXED, __HIP_MEMORY_SCOPE_AGENT); } }
        } else {
#pragma unroll
            for (int ai = 0; ai < 2; ++ai) {
                f32x4 bf[4][2][2];
#pragma unroll
                for (int m = 0; m < 4; ++m)
#pragma unroll
                    for (int bj = 0; bj < 2; ++bj) { const float* bp = (const float*)base + (size_t)(row0 + ai * HALF + m * 16) * 1024 + col0 + bj * HALF; bf[m][bj][0] = *(const f32x4*)bp; bf[m][bj][1] = *(const f32x4*)(bp + 4); }
#pragma unroll
                for (int m = 0; m < 4; ++m) { const int r = row0 + ai * HALF + m * 16; const size_t off = (size_t)r * 1024 + col0; float ss = 0.f;
#pragma unroll
                    for (int bj = 0; bj < 2; ++bj) finish(bf[m][bj][0], bf[m][bj][1], acc[ai][bj][m][0], acc[ai][bj][m][1], off + bj * HALF, ss);
                    if (rowss) { ss = sum_fq(ss); if (fq == 0) __hip_atomic_fetch_add(rowss + r, ss, __ATOMIC_RELAXED, __HIP_MEMORY_SCOPE_AGENT); } }
            }
        }
    }
};
struct EpiSwiGLU {
    static constexpr bool PERM = true, AFTER_DRAIN = false;
    const float* rowss; bf16_t* act; int ldo;
    __device__ __forceinline__ void operator()(const f32x4 (&acc)[2][2][4][2], const Unit& u, int wr, int wc, int fr, int fq) const {
        const int row0 = u.pm * BM + wr * 64 + fr, col0 = u.pn * HALF + wc * 32 + 8 * fq;
        float ssv[2][4];
#pragma unroll
        for (int ai = 0; ai < 2; ++ai)
#pragma unroll
            for (int m = 0; m < 4; ++m) ssv[ai][m] = ld_coherent(rowss + row0 + ai * HALF + m * 16);
#pragma unroll
        for (int ai = 0; ai < 2; ++ai)
#pragma unroll
            for (int m = 0; m < 4; ++m) { const int r = row0 + ai * HALF + m * 16;
                const float ss = ssv[ai][m] * (1.0f / 1024.0f) + 1e-6f, kk = -1.44269504089f * __builtin_amdgcn_rsqf(ss);
                float o[8];
#pragma unroll
                for (int n = 0; n < 2; ++n)
#pragma unroll
                    for (int e = 0; e < 4; ++e) { const float g = acc[ai][0][m][n][e], uu = acc[ai][1][m][n][e];
                        const float ex = __builtin_amdgcn_exp2f(g * kk); o[4 * n + e] = g * uu * __builtin_amdgcn_rcpf(ex * ss + ss); }
                u32x4 w; w.x = cvt_pk_bf16(o[0], o[1]); w.y = cvt_pk_bf16(o[2], o[3]); w.z = cvt_pk_bf16(o[4], o[5]); w.w = cvt_pk_bf16(o[6], o[7]);
                *(u32x4*)(act + (size_t)r * ldo + col0) = w; }
    }
};
struct EpiKVQ {
    static constexpr bool PERM = true, AFTER_DRAIN = false;
    unsigned char* ws;
    static constexpr size_t O_ROWSS = 64 * 1024 + (size_t)32768 * 4, O_GN = 768 * 1024 + 8192, O_ROPE = 1u << 20, O_KV = (size_t)128 << 20, O_Q = (size_t)224 << 20;
    __device__ __forceinline__ void operator()(const f32x4 (&acc)[2][2][4][2], const Unit& u, int wr, int wc, int fr, int fq) const {
        asm volatile("" : "+v"(fr), "+v"(fq));
        const float* rowss = (const float*)(ws + O_ROWSS); const float* cs = (const float*)(ws + O_ROPE); const float* sn = cs + (size_t)32768 * 16;
        PG8_LAS float* xl = (PG8_LAS float*)131072;
        const bool is_kv = u.pn < 6; bf16_t* base = (bf16_t*)(ws + (is_kv ? O_KV : O_Q)); const int ld = is_kv ? 1536 : 3072;
        const bool is_v = is_kv && (u.pn & 1); const int g = is_kv ? (u.pn >> 1) : ((u.pn - 6) >> 2);
        const int row0 = u.pm * BM + wr * 64 + fr, col0 = (is_kv ? u.pn : u.pn - 6) * BM + wc * 32 + 8 * fq;
        if (is_v) {
            float rv[2][4];
#pragma unroll
            for (int ai = 0; ai < 2; ++ai)
#pragma unroll
                for (int m = 0; m < 4; ++m) rv[ai][m] = ld_coherent(rowss + row0 + ai * HALF + m * 16);
#pragma unroll
            for (int ai = 0; ai < 2; ++ai)
#pragma unroll
                for (int m = 0; m < 4; ++m) { const int r = row0 + ai * HALF + m * 16;
                    const float rs = __builtin_amdgcn_rsqf(rv[ai][m] * (1.0f / 1024.0f) + 1e-6f);
                    bf16_t* rowp = base + (size_t)r * ld + col0;
#pragma unroll
                    for (int bj = 0; bj < 2; ++bj) { const f32x4 v0 = acc[ai][bj][m][0] * rs, v1 = acc[ai][bj][m][1] * rs;
                        u32x4 w; w.x = cvt_pk_bf16(v0[0], v0[1]); w.y = cvt_pk_bf16(v0[2], v0[3]); w.z = cvt_pk_bf16(v1[0], v1[1]); w.w = cvt_pk_bf16(v1[2], v1[3]);
                        *(u32x4*)(rowp + bj * HALF) = w; } }
            return;
        }
        f32x4 c0v[2][4], s0v[2][4];
#pragma unroll
        for (int ai = 0; ai < 2; ++ai)
#pragma unroll
            for (int m = 0; m < 4; ++m) { c0v[ai][m] = (f32x4){1.f, 1.f, 1.f, 1.f}; s0v[ai][m] = (f32x4){0.f, 0.f, 0.f, 0.f};
                if (fq == 0) { const size_t r_ = (size_t)(row0 + ai * HALF + m * 16); c0v[ai][m] = *(const f32x4*)(cs + r_ * 16 + 4 * wc); s0v[ai][m] = *(const f32x4*)(sn + r_ * 16 + 4 * wc); } }
        float rsv[2][4];
#pragma unroll
        for (int ai = 0; ai < 2; ++ai)
#pragma unroll
            for (int m = 0; m < 4; ++m) rsv[ai][m] = 1e-6f * (ld_coherent(rowss + row0 + ai * HALF + m * 16) * (1.0f / 1024.0f) + 1e-6f);
#pragma unroll
        for (int ai = 0; ai < 2; ++ai)
#pragma unroll
            for (int m = 0; m < 4; ++m)
#pragma unroll
                for (int bj = 0; bj < 2; ++bj) { const f32x4 a0 = acc[ai][bj][m][0], a1 = acc[ai][bj][m][1];
                    float ss = (a0[0] * a0[0] + a0[1] * a0[1]) + (a0[2] * a0[2] + a0[3] * a0[3]) + (a1[0] * a1[0] + a1[1] * a1[1]) + (a1[2] * a1[2] + a1[3] * a1[3]);
                    ss = sum_fq(ss);
                    if (fq == 0) xl[((ai * HALF + wr * 64 + m * 16 + fr) * 2 + bj) * 4 + wc] = ss; }
        asm volatile("s_waitcnt lgkmcnt(0)" ::: "memory"); __builtin_amdgcn_s_barrier(); asm volatile("" ::: "memory");
        const int d0 = (fq == 0) ? 4 * wc : 32 + 24 * wc + 8 * (fq - 1), d1 = (fq == 0) ? 16 + 4 * wc : d0 + 4;
        const float* gsrc = (const float*)(ws + O_GN) + (is_kv ? 0 : 384) + g * 128;
        const f32x4 gn0 = *(const f32x4*)(gsrc + d0), gn1 = *(const f32x4*)(gsrc + d1);
        const float qscale = is_kv ? 1.0f : 1.44269504089f * 0.08838834764831845f;
        const int tcol = (is_kv ? u.pn : u.pn - 6) * BM;
#pragma unroll
        for (int ai = 0; ai < 2; ++ai)
#pragma unroll
            for (int m = 0; m < 4; ++m) { const int rl = ai * HALF + wr * 64 + m * 16 + fr, r = u.pm * BM + rl;
                const float rs = rsv[ai][m];
                bf16_t* rowp = base + (size_t)r * ld + tcol;
                const f32x4 c0 = c0v[ai][m], s0 = s0v[ai][m];
#pragma unroll
                for (int bj = 0; bj < 2; ++bj) { const f32x4 pp = *(const PG8_LAS f32x4*)(xl + (rl * 2 + bj) * 4);
                    const float tot = (pp[0] + pp[1]) + (pp[2] + pp[3]);
                    const float f = __builtin_amdgcn_rsqf(tot * (1.0f / 128.0f) + rs) * qscale;
                    const f32x4 x1 = acc[ai][bj][m][0] * f * gn0, x2 = acc[ai][bj][m][1] * f * gn1;
                    if (fq == 0) { const f32x4 y1 = x1 * c0 - x2 * s0, y2 = x2 * c0 + x1 * s0;
                        u32x2 w1, w2; w1.x = cvt_pk_bf16(y1[0], y1[1]); w1.y = cvt_pk_bf16(y1[2], y1[3]); w2.x = cvt_pk_bf16(y2[0], y2[1]); w2.y = cvt_pk_bf16(y2[2], y2[3]);
                        *(u32x2*)(rowp + bj * HALF + d0) = w1; *(u32x2*)(rowp + bj * HALF + d1) = w2; }
                    else { u32x4 w; w.x = cvt_pk_bf16(x1[0], x1[1]); w.y = cvt_pk_bf16(x1[2], x1[3]); w.z = cvt_pk_bf16(x2[0], x2[1]); w.w = cvt_pk_bf16(x2[2], x2[3]);
                        *(u32x4*)(rowp + bj * HALF + d0) = w; } }
                }
    }
};

template <class Epi, class Sched, bool ALIGN_EPI = false, bool SP2 = false>
__device__ __forceinline__ void gemm_phase(PG8_LAS unsigned char* lds, const Gemm g, const Sched& S, const Epi& E) {
    int tid = threadIdx.x; asm volatile("" : "+v"(tid));
    const int wid = __builtin_amdgcn_readfirstlane(tid >> 6), lane = tid & 63, wr = wid >> 2, wc = wid & 3, fr = lane & 15, fq = lane >> 4;
    const int K = g.K, nt = K / BK;
    unsigned voffA[2], voffB[2];
#pragma unroll
    for (int i = 0; i < 2; ++i) { int R, C; stage_rc(tid * 16 + i * 8192, R, C); const int Rb = Epi::PERM ? ((R & ~31) + perm32(R & 31)) : R;
        voffA[i] = (unsigned)(R * K + C) * 2u; voffB[i] = (unsigned)(Rb * K + C) * 2u; }
    const size_t kstep = (size_t)(BK * 2);
    const size_t hstep = (size_t)HALF * K * 2;
    const size_t tstep = 2 * hstep;
    const unsigned ldsw = (unsigned)wid * 1024u;
    const int aoff = lds_byte(wr * 64 + fr, fq * 8), boff = lds_byte(wc * 32 + fr, fq * 8);
#define PG8_SA(b, h) (((b) * 2 + (h)) * HTB)
#define PG8_SB(b, h) ((4 + (b) * 2 + (h)) * HTB)
#define PG8_STAGE(bufoff, gbase, voff) do { _Pragma("unroll") for (int _i = 0; _i < 2; ++_i) \
        __builtin_amdgcn_global_load_lds((const unsigned*)((const char*)(gbase) + (voff)[_i]), (PG8_LAS unsigned*)(lds + (bufoff) + ldsw + _i * 8192), 16, 0, 0); } while (0)
#define PG8_LDA(dst, b, h) do { _Pragma("unroll") for (int m = 0; m < 4; ++m) _Pragma("unroll") for (int k = 0; k < 2; ++k) dst[m][k] = *(const PG8_LAS bf16x8*)(lds + PG8_SA(b, h) + aoff + m * 2048 + k * 1024); } while (0)
#define PG8_LDB(dst, b, h) do { _Pragma("unroll") for (int n = 0; n < 2; ++n) _Pragma("unroll") for (int k = 0; k < 2; ++k) dst[n][k] = *(const PG8_LAS bf16x8*)(lds + PG8_SB(b, h) + boff + n * 2048 + k * 1024); } while (0)
#define PG8_MMA(ai, bj, At, Bt) do { __builtin_amdgcn_s_setprio(1); _Pragma("unroll") for (int m = 0; m < 4; ++m) _Pragma("unroll") for (int n = 0; n < 2; ++n) _Pragma("unroll") for (int k = 0; k < 2; ++k) \
        acc[ai][bj][m][n] = __builtin_amdgcn_mfma_f32_16x16x32_bf16(Bt[n][k], At[m][k], acc[ai][bj][m][n], 0, 0, 0); __builtin_amdgcn_s_setprio(0); } while (0)
#define PG8_WAIT_V(n) asm volatile("s_waitcnt vmcnt(" #n ")" ::: "memory")
#define PG8_WAIT_L(n) asm volatile("s_waitcnt lgkmcnt(" #n ")" ::: "memory")
#define PG8_BAR __builtin_amdgcn_s_barrier()
#define PG8_SCHED __builtin_amdgcn_sched_barrier(0)
    Unit cur, nxt; int ui = 0;
    if (!S.next(0, cur)) return;
    f32x4 acc[2][2][4][2];
#pragma unroll
    for (int a = 0; a < 2; ++a)
#pragma unroll
        for (int b = 0; b < 2; ++b)
#pragma unroll
            for (int m = 0; m < 4; ++m)
#pragma unroll
                for (int n = 0; n < 2; ++n) acc[a][b][m][n] = (f32x4){0.f, 0.f, 0.f, 0.f};
    bf16x8 At[4][2], B0[2][2], B1[2][2];
    const char* cA = (const char*)g.A + (size_t)cur.pm * tstep; const char* cB = (const char*)g.Bt + (size_t)cur.pn * tstep;
    S.a_ready(cur);
    if constexpr (SP2) {
        PG8_STAGE(PG8_SB(0, 0), cB, voffB); PG8_STAGE(PG8_SB(0, 1), cB + hstep, voffB); PG8_STAGE(PG8_SA(0, 0), cA, voffA); PG8_STAGE(PG8_SA(0, 1), cA + hstep, voffA);
        if (wr == 1) PG8_BAR;
        PG8_WAIT_V(2); PG8_BAR;
        PG8_STAGE(PG8_SB(1, 0), cB + kstep, voffB); PG8_STAGE(PG8_SA(1, 0), cA + kstep, voffA); PG8_STAGE(PG8_SB(1, 1), cB + hstep + kstep, voffB);
        PG8_WAIT_V(6); PG8_BAR;
    } else {
        PG8_STAGE(PG8_SB(0, 0), cB, voffB); PG8_STAGE(PG8_SA(0, 0), cA, voffA); PG8_STAGE(PG8_SB(0, 1), cB + hstep, voffB); PG8_STAGE(PG8_SA(0, 1), cA + hstep, voffA);
        if (wr == 1) PG8_BAR;
        PG8_WAIT_V(4); PG8_BAR;
        PG8_STAGE(PG8_SB(1, 0), cB + kstep, voffB); PG8_STAGE(PG8_SA(1, 0), cA + kstep, voffA); PG8_STAGE(PG8_SB(1, 1), cB + hstep + kstep, voffB);
        PG8_WAIT_V(6); PG8_BAR;
    }
    for (;;) {
        const bool has_next = S.next(ui + 1, nxt);
        const char* nA = has_next ? (const char*)g.A + (size_t)nxt.pm * tstep : cA; const char* nB = has_next ? (const char*)g.Bt + (size_t)nxt.pn * tstep : cB;
        for (int t = 0; t < nt; t += 2) {
            const bool last = (t == nt - 2);
            const char* a1 = cA + (size_t)(t + 1) * kstep;
            const char* a2 = last ? nA : cA + (size_t)(t + 2) * kstep; const char* b2 = last ? nB : cB + (size_t)(t + 2) * kstep;
            const char* a3 = a2 + kstep; const char* b3 = b2 + kstep;
            if (last && has_next) S.a_ready(nxt);
            if constexpr (SP2) {
            PG8_LDB(B0, 0, 0); PG8_LDB(B1, 0, 1); PG8_SCHED; PG8_LDA(At, 0, 0); PG8_STAGE(PG8_SA(1, 1), a1 + hstep, voffA);
            PG8_WAIT_V(8); PG8_WAIT_L(0); PG8_BAR; PG8_MMA(0, 0, At, B0); PG8_MMA(0, 1, At, B1); PG8_BAR; PG8_SCHED;
            PG8_LDA(At, 0, 1); PG8_STAGE(PG8_SB(0, 0), b2, voffB); PG8_STAGE(PG8_SB(0, 1), b2 + hstep, voffB); PG8_STAGE(PG8_SA(0, 0), a2, voffA);
            PG8_WAIT_V(8); PG8_WAIT_L(0); PG8_BAR; PG8_MMA(1, 0, At, B0); PG8_MMA(1, 1, At, B1); PG8_BAR; PG8_SCHED;
            PG8_LDB(B0, 1, 0); PG8_LDB(B1, 1, 1); PG8_SCHED; PG8_LDA(At, 1, 0); PG8_STAGE(PG8_SA(0, 1), a2 + hstep, voffA);
            PG8_WAIT_V(8); PG8_WAIT_L(0); PG8_BAR; PG8_MMA(0, 0, At, B0); PG8_MMA(0, 1, At, B1); PG8_BAR; PG8_SCHED;
            PG8_LDA(At, 1, 1); PG8_STAGE(PG8_SB(1, 0), b3, voffB); PG8_STAGE(PG8_SB(1, 1), b3 + hstep, voffB); PG8_STAGE(PG8_SA(1, 0), a3, voffA);
            PG8_WAIT_V(8); PG8_WAIT_L(0); PG8_BAR; PG8_MMA(1, 0, At, B0); PG8_MMA(1, 1, At, B1); PG8_BAR; PG8_SCHED;
            } else {
            PG8_LDB(B0, 0, 0); PG8_SCHED; PG8_LDA(At, 0, 0); PG8_STAGE(PG8_SA(1, 1), a1 + hstep, voffA);
            PG8_WAIT_L(8); PG8_BAR; PG8_WAIT_L(0); PG8_MMA(0, 0, At, B0); PG8_BAR; PG8_SCHED;
            PG8_LDB(B1, 0, 1); PG8_STAGE(PG8_SB(0, 0), b2, voffB);
            PG8_BAR; PG8_WAIT_L(0); PG8_MMA(0, 1, At, B1); PG8_BAR;
            PG8_LDA(At, 0, 1); PG8_STAGE(PG8_SA(0, 0), a2, voffA);
            PG8_BAR; PG8_WAIT_L(0); PG8_MMA(1, 0, At, B0); PG8_BAR; PG8_SCHED;
            PG8_STAGE(PG8_SB(0, 1), b2 + hstep, voffB);
            PG8_WAIT_V(6); PG8_BAR; PG8_MMA(1, 1, At, B1); PG8_BAR;
            PG8_LDB(B0, 1, 0); PG8_SCHED; PG8_LDA(At, 1, 0); PG8_STAGE(PG8_SA(0, 1), a2 + hstep, voffA);
            PG8_WAIT_L(8); PG8_BAR; PG8_WAIT_L(0); PG8_MMA(0, 0, At, B0); PG8_BAR; PG8_SCHED;
            PG8_LDB(B1, 1, 1); PG8_STAGE(PG8_SB(1, 0), b3, voffB);
            PG8_BAR; PG8_WAIT_L(0); PG8_MMA(0, 1, At, B1); PG8_BAR;
            PG8_LDA(At, 1, 1); PG8_STAGE(PG8_SA(1, 0), a3, voffA);
            PG8_BAR; PG8_WAIT_L(0); PG8_MMA(1, 0, At, B0); PG8_BAR; PG8_SCHED;
            PG8_STAGE(PG8_SB(1, 1), b3 + hstep, voffB);
            PG8_WAIT_V(6); PG8_BAR; PG8_MMA(1, 1, At, B1); PG8_BAR;
            }
        }
        if constexpr (ALIGN_EPI) { if (wr == 0) PG8_BAR; }
        if constexpr (!Epi::AFTER_DRAIN) { E(acc, cur, wr, wc, fr, fq); S.done(cur); }
        if (!has_next) break;
#pragma unroll
        for (int a = 0; a < 2; ++a)
#pragma unroll
            for (int b = 0; b < 2; ++b)
#pragma unroll
                for (int m = 0; m < 4; ++m)
#pragma unroll
                    for (int n = 0; n < 2; ++n) acc[a][b][m][n] = (f32x4){0.f, 0.f, 0.f, 0.f};
        cur = nxt; cA = nA; cB = nB; ++ui;
        if constexpr (ALIGN_EPI) { if (wr == 1) PG8_BAR; }
    }
    PG8_WAIT_V(0);
    if constexpr (!ALIGN_EPI) { if (wr == 0) PG8_BAR; }
    PG8_BAR;
    if constexpr (Epi::AFTER_DRAIN) { E.fused(acc, cur, wr, wc, fr, fq, lds, wid, lane); S.done(cur); }
#undef PG8_SA
#undef PG8_SB
#undef PG8_STAGE
#undef PG8_LDA
#undef PG8_LDB
#undef PG8_MMA
#undef PG8_WAIT_V
#undef PG8_WAIT_L
#undef PG8_BAR
#undef PG8_SCHED
}
}

#define LAS __attribute__((address_space(3)))
typedef unsigned short bf16_t;
typedef short bf16x8 __attribute__((ext_vector_type(8)));
typedef short s16x4 __attribute__((ext_vector_type(4)));
typedef float f32x4 __attribute__((ext_vector_type(4)));
typedef float f32x2 __attribute__((ext_vector_type(2)));
typedef unsigned u32x4 __attribute__((ext_vector_type(4)));
typedef unsigned u32x2 __attribute__((ext_vector_type(2)));

constexpr int SEQ = 16384, NB = 2, T = NB * SEQ, D = 1024, FF = 2816, NKV = 1536, NQ = 3072, NKVQ = NKV + NQ;
constexpr int NWAVES = 8, NTHR = 512;
constexpr int LDS_BYTES = 148480;
constexpr float EPS = 1e-6f;

constexpr size_t MiB = 1u << 20;
constexpr size_t WS_BAR = 0;
constexpr size_t WS_ROWSS = 64 * 1024;
constexpr size_t WS_GN = 768 * 1024 + 8192;
constexpr size_t WS_SP = 768 * 1024;
constexpr size_t WS_ROPE = 1 * MiB;
constexpr size_t WS_AGG = 5 * MiB;
constexpr size_t WS_LSE = 7 * MiB;
constexpr size_t WS_GW = 10 * MiB;
constexpr size_t WS_W1 = 11 * MiB;
constexpr size_t WS_W2 = 15 * MiB;
constexpr size_t WS_W3 = 17 * MiB;
constexpr size_t WS_W4 = 28 * MiB;
constexpr size_t WS_W5 = 34 * MiB;
constexpr size_t WS_W6 = 43 * MiB;
constexpr size_t WS_W7 = 45 * MiB;
constexpr size_t WS_W8 = 56 * MiB;
constexpr size_t WS_PB = 62 * MiB;
constexpr size_t WS_XA = 64 * MiB;
constexpr size_t WS_G = 128 * MiB, WS_XB = 192 * MiB, WS_YA = 384 * MiB;
constexpr size_t WS_ACT = 128 * MiB;
constexpr size_t WS_KV = 128 * MiB, WS_QO = 224 * MiB, WS_OM = 416 * MiB;
constexpr size_t WS_END = 480 * MiB;
static_assert(pg8::EpiKVQ::O_ROWSS == WS_ROWSS + (size_t)T * 4 && pg8::EpiKVQ::O_GN == WS_GN && pg8::EpiKVQ::O_ROPE == WS_ROPE && pg8::EpiKVQ::O_KV == WS_KV && pg8::EpiKVQ::O_Q == WS_QO, "EpiKVQ offsets");

__device__ __forceinline__ float bf_lo(unsigned w) { return __uint_as_float(w << 16); }
__device__ __forceinline__ float bf_hi(unsigned w) { return __uint_as_float(w & 0xffff0000u); }
__device__ __forceinline__ unsigned pk2(float lo, float hi) { return pg8::cvt_pk_bf16(lo, hi); }
__device__ __forceinline__ float wave_sum(float v) {
#pragma unroll
    for (int o = 1; o < 64; o <<= 1) v += __shfl_xor(v, o);
    return v;
}
__device__ __forceinline__ float fsig(float x) { return __builtin_amdgcn_rcpf(1.0f + __builtin_amdgcn_exp2f(-1.44269504089f * x)); }

#define LDS_BARRIER() do { asm volatile("s_waitcnt lgkmcnt(0)" ::: "memory"); __builtin_amdgcn_s_barrier(); asm volatile("" ::: "memory"); } while (0)

struct Params {
    const float* in[25];
    float* out;
    unsigned char* ws;
    double invf[16];
};

__device__ __forceinline__ int hperm_row(int row) { const int d = row & 127; const int c = d < 32 ? 32 * ((d & 15) >> 2) + 4 * (d >> 4) + (d & 3) : 32 * ((d - 32) / 24) + 8 + ((d - 32) % 24); return (row & ~127) + c; }
__device__ __forceinline__ void wt_item(const float* W, int K, int N, bf16_t* WT, int dst_row0, const float* gain, LAS float* scr, int kb, int nb, int lane, bool hperm = false, float wscale = 1.0f) {
    const int k0 = 64 * kb, n0 = 32 * nb;
    { const int kk = lane >> 3, c4 = 4 * (lane & 7);
      f32x4 v[8];
#pragma unroll
      for (int i = 0; i < 8; ++i) v[i] = *(const f32x4*)(W + (size_t)(k0 + kk + 8 * i) * N + n0 + c4);
#pragma unroll
      for (int i = 0; i < 8; ++i) { const float gsc = gain ? gain[k0 + kk + 8 * i] : wscale; LAS float* d = scr + (kk + 8 * i) * 33 + c4;
          d[0] = v[i].x * gsc; d[1] = v[i].y * gsc; d[2] = v[i].z * gsc; d[3] = v[i].w * gsc; } }
    asm volatile("s_waitcnt lgkmcnt(0)" ::: "memory");
    const int c = lane & 7;
#pragma unroll
    for (int j = 0; j < 4; ++j) { const int n = (lane >> 3) + 8 * j; const LAS float* s = scr + (8 * c) * 33 + n;
        u32x4 o; o.x = pk2(s[0 * 33], s[1 * 33]); o.y = pk2(s[2 * 33], s[3 * 33]); o.z = pk2(s[4 * 33], s[5 * 33]); o.w = pk2(s[6 * 33], s[7 * 33]);
        const int drow = hperm ? hperm_row(dst_row0 + n) : dst_row0 + n;
        *(u32x4*)(WT + (size_t)drow * K + k0 + 8 * c) = o; }
    asm volatile("s_waitcnt lgkmcnt(0)" ::: "memory");
}

__device__ __forceinline__ void p0_prologue(const Params& P, LAS unsigned char* lds, int vcu, int G, int wave, int lane) {
    unsigned char* ws = P.ws;
    LAS float* scr = (LAS float*)(lds + wave * 16384);
    const int gw = vcu * NWAVES + wave, NGW = G * NWAVES;
    constexpr int C1 = (D / 64) * (2048 / 32), C2 = (D / 64) * (D / 32), C3 = (D / 64) * (2 * FF / 32), C4 = (FF / 64) * (D / 32), C5 = (D / 64) * (NKV / 32), C6 = (D / 64) * (NQ / 32), CG = 128;
    constexpr int NITEMS = C1 + C2 + C3 + C4 + C5 + C6 + C2 + C3 + C4 + CG;
    for (int it = gw; it < NITEMS; it += NGW) {
        int r = it;
        if (r < C1) { wt_item(P.in[3], D, 2048, (bf16_t*)(ws + WS_W1), (r % 64) * 32, nullptr, scr, r / 64, r % 64, lane); continue; } r -= C1;
        if (r < C2) { wt_item(P.in[11], D, D, (bf16_t*)(ws + WS_W2), (r % 32) * 32, nullptr, scr, r / 32, r % 32, lane); continue; } r -= C2;
        if (r < C3) { const int nb = r % 176, n0 = nb * 32, j = n0 < FF ? n0 : n0 - FF, dr = 256 * (j / 128) + (n0 < FF ? 0 : 128) + (j % 128);
            wt_item(P.in[13], D, 2 * FF, (bf16_t*)(ws + WS_W3), dr, P.in[12], scr, r / 176, nb, lane); continue; } r -= C3;
        if (r < C4) { wt_item(P.in[14], FF, D, (bf16_t*)(ws + WS_W4), (r % 32) * 32, nullptr, scr, r / 32, r % 32, lane); continue; } r -= C4;
        if (r < C5) { const int n0 = (r % 48) * 32; wt_item(P.in[16], D, NKV, (bf16_t*)(ws + WS_W5), n0, P.in[15], scr, r / 48, r % 48, lane, ((n0 >> 8) & 1) == 0); continue; } r -= C5;
        if (r < C6) { wt_item(P.in[19], D, NQ, (bf16_t*)(ws + WS_W5), NKV + (r % 96) * 32, P.in[18], scr, r / 96, r % 96, lane, true); continue; } r -= C6;
        if (r < C2) { wt_item(P.in[21], D, D, (bf16_t*)(ws + WS_W6), (r % 32) * 32, nullptr, scr, r / 32, r % 32, lane); continue; } r -= C2;
        if (r < C3) { const int nb = r % 176, n0 = nb * 32, j = n0 < FF ? n0 : n0 - FF, dr = 256 * (j / 128) + (n0 < FF ? 0 : 128) + (j % 128);
            wt_item(P.in[23], D, 2 * FF, (bf16_t*)(ws + WS_W7), dr, P.in[22], scr, r / 176, nb, lane); continue; } r -= C3;
        if (r < C4) { wt_item(P.in[24], FF, D, (bf16_t*)(ws + WS_W8), (r % 32) * 32, nullptr, scr, r / 32, r % 32, lane); continue; } r -= C4;
        { const int mat = r >> 3, which = mat >> 3, hh = mat & 7, rr = r & 7, kb = rr >> 2, nb = rr & 3;
          wt_item((which ? P.in[8] : P.in[6]) + hh * 16384, 128, 128, (bf16_t*)(ws + WS_GW) + hh * 256 * 128, which * 128 + nb * 32, nullptr, scr, kb, nb, lane, false, -1.44269504089f); }
    }
    {
        const float* x = P.in[0]; const float* gn = P.in[2]; bf16_t* XA = (bf16_t*)(ws + WS_XA);
        f32x4 gv[4];
#pragma unroll
        for (int j = 0; j < 4; ++j) gv[j] = *((const f32x4*)gn + lane + 64 * j);
        f32x4 v[2][4];
        if (2 * gw < T) { const f32x4* xr = (const f32x4*)(x + (size_t)(2 * gw) * D) + lane;
#pragma unroll
            for (int j = 0; j < 4; ++j) { v[0][j] = xr[64 * j]; v[1][j] = xr[256 + 64 * j]; } }
        for (int m = 2 * gw; m < T; m += 2 * NGW) {
            f32x4 vn[2][4]; const bool more = m + 2 * NGW < T;
            if (more) { const f32x4* xr = (const f32x4*)(x + (size_t)(m + 2 * NGW) * D) + lane;
#pragma unroll
                for (int j = 0; j < 4; ++j) { vn[0][j] = xr[64 * j]; vn[1][j] = xr[256 + 64 * j]; } }
            float s0 = 0.f, s1 = 0.f;
#pragma unroll
            for (int j = 0; j < 4; ++j) { s0 += (v[0][j].x * v[0][j].x + v[0][j].y * v[0][j].y) + (v[0][j].z * v[0][j].z + v[0][j].w * v[0][j].w);
                s1 += (v[1][j].x * v[1][j].x + v[1][j].y * v[1][j].y) + (v[1][j].z * v[1][j].z + v[1][j].w * v[1][j].w); }
            const float rs0 = 1.0f / sqrtf(wave_sum(s0) * (1.0f / D) + EPS), rs1 = 1.0f / sqrtf(wave_sum(s1) * (1.0f / D) + EPS);
            u32x2* o8 = (u32x2*)(XA + (size_t)m * D) + lane;
#pragma unroll
            for (int j = 0; j < 4; ++j) { u32x2 w; w.x = pk2(v[0][j].x * rs0 * gv[j].x, v[0][j].y * rs0 * gv[j].y); w.y = pk2(v[0][j].z * rs0 * gv[j].z, v[0][j].w * rs0 * gv[j].w); o8[64 * j] = w;
                u32x2 w2; w2.x = pk2(v[1][j].x * rs1 * gv[j].x, v[1][j].y * rs1 * gv[j].y); w2.y = pk2(v[1][j].z * rs1 * gv[j].z, v[1][j].w * rs1 * gv[j].w); o8[256 + 64 * j] = w2; }
            if (more) {
#pragma unroll
                for (int j = 0; j < 4; ++j) { v[0][j] = vn[0][j]; v[1][j] = vn[1][j]; } }
        }
    }
    const int gt = gw * 64 + lane, NGT = NGW * 64;
    { float* rowss = (float*)(ws + WS_ROWSS); for (int i = gt; i < 3 * T; i += NGT) rowss[i] = 0.f; }
    { u32x4* z0 = (u32x4*)(ws + WS_AGG); u32x4* z1 = (u32x4*)(ws + WS_PB); for (int i = gt; i < 131072; i += NGT) { z0[i] = (u32x4){0u, 0u, 0u, 0u}; z1[i] = (u32x4){0u, 0u, 0u, 0u}; } }
    { float* cs = (float*)(ws + WS_ROPE); float* sn = cs + (size_t)T * 16; const int* pos = (const int*)P.in[1];
      for (int i = gt; i < T * 16; i += NGT) { const int m = i >> 4, f = i & 15;
          const double rev = (double)pos[m] * P.invf[f] * 0.15915494309189535;
          const float fr = (float)(rev - __builtin_rint(rev));
          cs[i] = __builtin_amdgcn_cosf(fr); sn[i] = __builtin_amdgcn_sinf(fr); } }
    { float* gn = (float*)(ws + WS_GN); for (int i = gt; i < 768; i += NGT) gn[i] = i < 384 ? P.in[17][i] : P.in[20][i - 384]; }
    if (gt < 3) { float mk = 0.f, mq = 0.f; for (int i = 0; i < 128; ++i) { mk = fmaxf(mk, fabsf(P.in[17][gt * 128 + i])); mq = fmaxf(mq, fabsf(P.in[20][gt * 128 + i])); }
        ((float*)(ws + WS_GN))[768 + gt] = fminf(60.0f, 1.03f * 1.44269504089f * 11.3137085f * mk * mq); }
    { float* sp = (float*)(ws + WS_SP); const float* lam = P.in[10];
      for (int i = gt; i < 1024; i += NGT) { const float z = -lam[i]; sp[i] = 8.0f * (z > 15.f ? z : log1pf(__expf(z))); } }
}

__device__ __forceinline__ void scan_phase(const Params& P, LAS unsigned char* lds, int vcu, int G, int tid, int wave, int lane) {
    unsigned char* ws = P.ws;
    const bf16_t* XB = (const bf16_t*)(ws + WS_XB); const bf16_t* GW = (const bf16_t*)(ws + WS_GW);
    const float* conv_w = P.in[4]; const float* conv_b = P.in[5]; const float* ga_b = P.in[7]; const float* gx_b = P.in[9]; const float* SP = (const float*)(ws + WS_SP);
    unsigned long long* AH = (unsigned long long*)(ws + WS_AGG); unsigned long long* PP = (unsigned long long*)(ws + WS_PB);
    const bf16_t* Gt = (const bf16_t*)(ws + WS_G); bf16_t* YA = (bf16_t*)(ws + WS_YA);
    asm volatile("" : "+v"(tid), "+v"(lane));
    constexpr int AOFF = 0, BOFF = 128 * 272, LAOFF = 0, LUOFF = 128 * 132 * 4, SEGOFF = 2 * 128 * 132 * 4;
    const int fr = lane & 15, fq = lane >> 4, wm = wave >> 2, wn = wave & 3;
    const int blk0 = vcu & 7;
    const bf16_t* gwb = GW + (size_t)blk0 * 256 * 128 + (32 * wn + fr) * 128 + 8 * fq;
    const int c8 = tid & 15, tr = tid >> 4;
    u32x4 xw[7];
#define SCAN_LOAD_X(uu) do { const int ck_ = ((uu) >> 3) & 127, b_ = (uu) >> 10; \
        _Pragma("unroll") for (int ri = 0; ri < 7; ++ri) { int sl_ = ck_ * 128 + 4 * tr - 3 + ri; sl_ = sl_ < 0 ? 0 : sl_; xw[ri] = *(const u32x4*)(XB + ((size_t)(b_ * SEQ + sl_)) * D + blk0 * 128 + 8 * c8); } } while (0)
    LAS float* CT = (LAS float*)(lds + 143360);
    for (int i = tid; i < 1024; i += NTHR) { float v;
        if (i < 512) v = conv_w[(i >> 7) * D + blk0 * 128 + (i & 127)]; else if (i < 640) v = conv_b[blk0 * 128 + (i - 512)]; else if (i < 768) v = SP[blk0 * 128 + (i - 640)] * -1.44269504089f;
        else if (i < 896) v = ga_b[blk0 * 128 + (i - 768)] * -1.44269504089f; else v = gx_b[blk0 * 128 + (i - 896)] * -1.44269504089f;
        CT[i] = v; }
    if (vcu < 2048) SCAN_LOAD_X(vcu);
    LDS_BARRIER();
    for (int u = vcu; u < 2048; u += G) {
        const int blk = blk0, ck = (u >> 3) & 127, b = u >> 10;
        const int m0 = b * SEQ + ck * 128, c0 = blk * 128;
        {
            const int ch = c0 + 8 * c8;
            float xr[7][8];
#pragma unroll
            for (int ri = 0; ri < 7; ++ri) { const u32x4 w = (ck * 128 + 4 * tr - 3 + ri >= 0) ? xw[ri] : (u32x4){0u, 0u, 0u, 0u};
                xr[ri][0] = bf_lo(w.x); xr[ri][1] = bf_hi(w.x); xr[ri][2] = bf_lo(w.y); xr[ri][3] = bf_hi(w.y); xr[ri][4] = bf_lo(w.z); xr[ri][5] = bf_hi(w.z); xr[ri][6] = bf_lo(w.w); xr[ri][7] = bf_hi(w.w); }
            float acc[4][8];
            { const f32x4 b0 = *(const LAS f32x4*)(CT + 512 + 8 * c8), b1 = *(const LAS f32x4*)(CT + 512 + 8 * c8 + 4);
#pragma unroll
              for (int j = 0; j < 4; ++j) { acc[j][0] = b0.x; acc[j][1] = b0.y; acc[j][2] = b0.z; acc[j][3] = b0.w; acc[j][4] = b1.x; acc[j][5] = b1.y; acc[j][6] = b1.z; acc[j][7] = b1.w; } }
#pragma unroll
            for (int k = 0; k < 4; ++k) { const f32x4 w0 = *(const LAS f32x4*)(CT + k * 128 + 8 * c8), w1 = *(const LAS f32x4*)(CT + k * 128 + 8 * c8 + 4);
                const float wk[8] = {w0.x, w0.y, w0.z, w0.w, w1.x, w1.y, w1.z, w1.w};
#pragma unroll
                for (int j = 0; j < 4; ++j)
#pragma unroll
                    for (int e = 0; e < 8; ++e) acc[j][e] += wk[e] * xr[j + k][e]; }
#pragma unroll
            for (int j = 0; j < 4; ++j) { u32x4 w; w.x = pk2(acc[j][0], acc[j][1]); w.y = pk2(acc[j][2], acc[j][3]); w.z = pk2(acc[j][4], acc[j][5]); w.w = pk2(acc[j][6], acc[j][7]);
                *(LAS u32x4*)(lds + AOFF + (4 * tr + j) * 272 + c8 * 16) = w; }
        }
        asm volatile("" ::: "memory");
        bf16x8 wrf[4][2], wif[4][2];
#pragma unroll
        for (int ks = 0; ks < 4; ++ks)
#pragma unroll
            for (int nt = 0; nt < 2; ++nt) { wrf[ks][nt] = *(const bf16x8*)(gwb + nt * 16 * 128 + 32 * ks); wif[ks][nt] = *(const bf16x8*)(gwb + (128 + nt * 16) * 128 + 32 * ks); }
        LDS_BARRIER();
        u32x4 gq[4];
#pragma unroll
        for (int j = 0; j < 4; ++j) gq[j] = *(const u32x4*)(Gt + (size_t)(m0 + 4 * tr + j) * D + c0 + 8 * c8);
        f32x4 ar[4][2], ai[4][2];
#pragma unroll
        for (int mt = 0; mt < 4; ++mt)
#pragma unroll
            for (int nt = 0; nt < 2; ++nt) { ar[mt][nt] = *(const LAS f32x4*)(CT + 768 + 32 * wn + 16 * nt + 4 * fq); ai[mt][nt] = *(const LAS f32x4*)(CT + 896 + 32 * wn + 16 * nt + 4 * fq); }
        asm volatile("" ::: "memory");
        { const int un = (u + G < 2048) ? u + G : 2047; SCAN_LOAD_X(un); }
        asm volatile("" ::: "memory");
#pragma unroll
        for (int ks = 0; ks < 4; ++ks) {
            bf16x8 xf[4];
#pragma unroll
            for (int mt = 0; mt < 4; ++mt) xf[mt] = *(const LAS bf16x8*)(lds + AOFF + (64 * wm + 16 * mt + fr) * 272 + (32 * ks + 8 * fq) * 2);
#pragma unroll
            for (int mt = 0; mt < 4; ++mt)
#pragma unroll
                for (int nt = 0; nt < 2; ++nt) { ar[mt][nt] = __builtin_amdgcn_mfma_f32_16x16x32_bf16(wrf[ks][nt], xf[mt], ar[mt][nt], 0, 0, 0);
                    ai[mt][nt] = __builtin_amdgcn_mfma_f32_16x16x32_bf16(wif[ks][nt], xf[mt], ai[mt][nt], 0, 0, 0); }
        }
        u32x2 xcv[4][2];
#pragma unroll
        for (int mt = 0; mt < 4; ++mt)
#pragma unroll
            for (int nt = 0; nt < 2; ++nt) xcv[mt][nt] = *(const LAS u32x2*)(lds + AOFF + (64 * wm + 16 * mt + fr) * 272 + (32 * wn + 16 * nt + 4 * fq) * 2);
        LDS_BARRIER();
#pragma unroll
        for (int nt = 0; nt < 2; ++nt) {
            const int chl = 32 * wn + 16 * nt + 4 * fq;
            const f32x4 sp = *(const LAS f32x4*)(CT + 640 + chl);
#pragma unroll
            for (int mt = 0; mt < 4; ++mt) { const int tok = 64 * wm + 16 * mt + fr;
                const float xc[4] = {bf_lo(xcv[mt][nt].x), bf_hi(xcv[mt][nt].x), bf_lo(xcv[mt][nt].y), bf_hi(xcv[mt][nt].y)};
                f32x4 av, uv;
#pragma unroll
                for (int e = 0; e < 4; ++e) { const float rg = __builtin_amdgcn_rcpf(1.0f + __builtin_amdgcn_exp2f(ar[mt][nt][e])), ig = __builtin_amdgcn_rcpf(1.0f + __builtin_amdgcn_exp2f(ai[mt][nt][e]));
                    const float l2 = sp[e] * rg;
                    const float a = __builtin_amdgcn_exp2f(l2), a2 = a * a;
                    av[e] = a; uv[e] = __builtin_amdgcn_sqrtf(fmaxf(1.0f - a2, 0.f)) * ig * xc[e]; }
                *(LAS f32x4*)(lds + LAOFF + (tok * 132 + chl) * 4) = av; *(LAS f32x4*)(lds + LUOFF + (tok * 132 + chl) * 4) = uv; }
        }
        LDS_BARRIER();
        int t2 = tid; asm volatile("" : "+v"(t2));
        const int ch = t2 & 127, seg = __builtin_amdgcn_readfirstlane(t2 >> 7);
        LAS float* La = (LAS float*)(lds + LAOFF); LAS float* Lu = (LAS float*)(lds + LUOFF); LAS float* Sg = (LAS float*)(lds + SEGOFF);
        { float h = 0.f, A = 1.f;
#pragma unroll 8
          for (int j = 0; j < 32; ++j) { const int o = (32 * seg + j) * 132 + ch; const float a = La[o], uu = Lu[o]; h = a * h + uu; A *= a; La[o] = A; Lu[o] = h; }
          Sg[seg * 128 + ch] = A; Sg[512 + seg * 128 + ch] = h; }
        LDS_BARRIER();
        float cA = 1.f, cH = 0.f;
        for (int s2 = 0; s2 < seg; ++s2) { const float a = Sg[s2 * 128 + ch], hh = Sg[512 + s2 * 128 + ch]; cH = a * cH + hh; cA *= a; }
        const int ck0 = ck & ~31, nprev = ck - ck0;
        const size_t ao = (size_t)(b * 128 + ck) * 1024 + c0 + ch;
        float Atot = 0.f, Hend = 0.f;
        if (seg == 3) { const int o = 127 * 132 + ch; Atot = La[o] * cA; Hend = Lu[o] + La[o] * cH;
            __hip_atomic_store(AH + ao, ((unsigned long long)__float_as_uint(Hend) << 32) | (unsigned long long)(__float_as_uint(Atot) | 1u), __ATOMIC_RELAXED, __HIP_MEMORY_SCOPE_AGENT); }
        float C = 0.f;
        { const int q0 = 8 * seg, q1 = (q0 + 8 < nprev) ? q0 + 8 : nprev;
          const unsigned long long* ap = AH + (size_t)(b * 128 + ck0) * 1024 + c0 + ch;
          const unsigned long long* pq = PP + (size_t)(b * 128 + ck0 - 1) * 1024 + c0 + ch;
          unsigned long long av[8], pw = 1ull; unsigned spins = 0;
          for (;;) {
              bool ok = true;
#pragma unroll
              for (int q = 0; q < 8; ++q) { av[q] = 1ull; if (q0 + q < q1) av[q] = __hip_atomic_load(ap + (size_t)(q0 + q) * 1024, __ATOMIC_RELAXED, __HIP_MEMORY_SCOPE_AGENT); }
              if (ck0 > 0) pw = __hip_atomic_load(pq, __ATOMIC_RELAXED, __HIP_MEMORY_SCOPE_AGENT);
#pragma unroll
              for (int q = 0; q < 8; ++q) ok = ok && ((unsigned)av[q] != 0u);
              ok = ok && ((unsigned)pw != 0u);
              if (__all(ok)) break;
              __builtin_amdgcn_s_sleep(1);
              if (++spins > (1u << 18)) break;
          }
          float fA = 1.f, fH = 0.f;
#pragma unroll
          for (int q = 0; q < 8; ++q) if (q0 + q < q1) { const float a2 = __uint_as_float((unsigned)av[q]), h2 = __uint_as_float((unsigned)(av[q] >> 32)); fH = a2 * fH + h2; fA *= a2; }
          Sg[1024 + seg * 128 + ch] = fA; Sg[1536 + seg * 128 + ch] = fH;
          if (ck0 > 0) C = __uint_as_float((unsigned)(pw >> 32)); }
        LDS_BARRIER();
#pragma unroll
        for (int s2 = 0; s2 < 4; ++s2) C = Sg[1024 + s2 * 128 + ch] * C + Sg[1536 + s2 * 128 + ch];
        if (seg == 3) __hip_atomic_store(PP + ao, ((unsigned long long)__float_as_uint(Atot * C + Hend) << 32) | 0x3f800000ull, __ATOMIC_RELAXED, __HIP_MEMORY_SCOPE_AGENT);
        Sg[seg * 128 + ch] = cA * C + cH;
        LDS_BARRIER();
        const f32x4 cc0 = *(const LAS f32x4*)(Sg + (tr >> 3) * 128 + 8 * c8), cc1 = *(const LAS f32x4*)(Sg + (tr >> 3) * 128 + 8 * c8 + 4);
#pragma unroll
        for (int j = 0; j < 4; ++j) { const LAS float* hp = Lu + (4 * tr + j) * 132 + 8 * c8; const LAS float* ap = La + (4 * tr + j) * 132 + 8 * c8;
            const f32x4 h0 = *(const LAS f32x4*)hp + *(const LAS f32x4*)ap * cc0, h1 = *(const LAS f32x4*)(hp + 4) + *(const LAS f32x4*)(ap + 4) * cc1; const u32x4 g = gq[j];
            u32x4 w; w.x = pk2(bf_lo(g.x) * h0.x, bf_hi(g.x) * h0.y); w.y = pk2(bf_lo(g.y) * h0.z, bf_hi(g.y) * h0.w); w.z = pk2(bf_lo(g.z) * h1.x, bf_hi(g.z) * h1.y); w.w = pk2(bf_lo(g.w) * h1.z, bf_hi(g.w) * h1.w);
            *(u32x4*)(YA + (size_t)(m0 + 4 * tr + j) * D + c0 + 8 * c8) = w; }
        LDS_BARRIER();
    }
#undef SCAN_LOAD_X
}

struct XcdBarrier; __device__ __forceinline__ void xcd_barrier(const XcdBarrier& b);
__device__ __forceinline__ void attn_phase(const Params& P, LAS unsigned char* lds, int vcu, int G, int tid, int wave, int lane, const XcdBarrier& xbar) {
    unsigned char* ws = P.ws;
    asm volatile("" : "+v"(tid), "+v"(lane));
    const bf16_t* KV = (const bf16_t*)(ws + WS_KV); bf16_t* QO = (bf16_t*)(ws + WS_QO);
    constexpr int KROW = 272, VROW = 288, VOFF = 64 * KROW, SLOT = 64 * KROW + 64 * VROW;
    constexpr float NEG = -3.0e38f;
    const int fr = lane & 15, fq = lane >> 4;
    const int j = wave >> 1, q0 = 32 * (wave & 1);
    const int c16 = tid & 15, rr = tid >> 4;
    bool synced = false;
#pragma unroll 1
    for (int chain = vcu; chain < 768; chain += G) {
        const int g = chain >> 8, r8 = chain & 255, dsh = 2 * g;
        if (g == 2 && !synced) { xcd_barrier(xbar); synced = true; }

        const int cc = r8 & ((64 >> dsh) - 1), stream = r8 >> (6 - dsh), h = stream & 1, p = (stream >> 1) & ((1 << dsh) - 1), b = stream >> (1 + dsh);
        const size_t mb = (size_t)b * SEQ + p; const int hq = 4 * h + j, m0 = 4 * cc;
        const bf16_t* kvb = KV + g * 512 + h * 128 + 8 * c16;
        const float nsh = __uint_as_float((unsigned)__builtin_amdgcn_readfirstlane((int)__float_as_uint(-((const float*)(ws + WS_GN))[768 + g])));
        bf16_t* qob = QO + g * 1024 + hq * 128;
        bf16x8 qf[2][4];
#pragma unroll
        for (int qt = 0; qt < 2; ++qt) { const bf16_t* qp = qob + (mb + ((size_t)(64 * m0 + q0 + 16 * qt + fr) << dsh)) * NQ + 8 * fq;
#pragma unroll
            for (int ks = 0; ks < 4; ++ks) qf[qt][ks] = *(const bf16x8*)(qp + 32 * ks); }
        {
            u32x4 kw[6], vw[6];
#pragma unroll
            for (int t = 0; t < 3; ++t)
#pragma unroll
                for (int e = 0; e < 2; ++e) { const int tk = m0 - 2 + t, row = rr + 32 * e;
                    kw[2 * t + e] = (u32x4){0u, 0u, 0u, 0u}; vw[2 * t + e] = (u32x4){0u, 0u, 0u, 0u};
                    if (tk >= 0) { const bf16_t* kp = kvb + (mb + ((size_t)(64 * tk + row) << dsh)) * NKV; kw[2 * t + e] = *(const u32x4*)kp; vw[2 * t + e] = *(const u32x4*)(kp + 256); } }
#pragma unroll
            for (int t = 0; t < 3; ++t)
#pragma unroll
                for (int e = 0; e < 2; ++e) { const int sl = (m0 + 2 + t) & 3, row = rr + 32 * e;
                    *(LAS u32x4*)(lds + sl * SLOT + row * KROW + c16 * 16) = kw[2 * t + e]; *(LAS u32x4*)(lds + sl * SLOT + VOFF + row * VROW + c16 * 16) = vw[2 * t + e]; }
        }
        LDS_BARRIER();
#pragma unroll 1
        for (int i = 0; i < 4; ++i) {
            const int m64 = m0 + i;
            u32x4 kn[2], vn[2]; bf16x8 qn[2][4];
            if (i < 3) {
#pragma unroll
                for (int e = 0; e < 2; ++e) { const bf16_t* kp = kvb + (mb + ((size_t)(64 * (m64 + 1) + rr + 32 * e) << dsh)) * NKV; kn[e] = *(const u32x4*)kp; vn[e] = *(const u32x4*)(kp + 256); }
#pragma unroll
                for (int qt = 0; qt < 2; ++qt) { const bf16_t* qp = qob + (mb + ((size_t)(64 * (m64 + 1) + q0 + 16 * qt + fr) << dsh)) * NQ + 8 * fq;
#pragma unroll
                    for (int ks = 0; ks < 4; ++ks) qn[qt][ks] = *(const bf16x8*)(qp + 32 * ks); }
            }
            f32x4 s[10][2];
#pragma unroll
            for (int kt = 0; kt < 10; ++kt) { s[kt][0] = (kt <= 8) ? (f32x4){nsh, nsh, nsh, nsh} : (f32x4){0.f, 0.f, 0.f, 0.f}; s[kt][1] = (kt >= 1) ? (f32x4){nsh, nsh, nsh, nsh} : (f32x4){0.f, 0.f, 0.f, 0.f}; }
#pragma unroll
            for (int kt = 0; kt < 10; ++kt) {
                const int k0 = q0 + 16 * kt, sl = (m64 + 2 + (k0 >> 6)) & 3;
                const LAS unsigned char* kb = lds + sl * SLOT + ((k0 & 63) + fr) * KROW + 16 * fq;
#pragma unroll
                for (int ks = 0; ks < 4; ++ks) { const bf16x8 kf = *(const LAS bf16x8*)(kb + 64 * ks);
                    if (kt <= 8) s[kt][0] = __builtin_amdgcn_mfma_f32_16x16x32_bf16(kf, qf[0][ks], s[kt][0], 0, 0, 0);
                    if (kt >= 1) s[kt][1] = __builtin_amdgcn_mfma_f32_16x16x32_bf16(kf, qf[1][ks], s[kt][1], 0, 0, 0); }
            }
            if (i < 3) {
                const int sl = (m64 + 1) & 3;
#pragma unroll
                for (int e = 0; e < 2; ++e) { const int row = rr + 32 * e;
                    *(LAS u32x4*)(lds + sl * SLOT + row * KROW + c16 * 16) = kn[e]; *(LAS u32x4*)(lds + sl * SLOT + VOFF + row * VROW + c16 * 16) = vn[e]; }
            }
            int dl = fr - 4 * fq, thr = 128 - 64 * m64 - q0 - 4 * fq;
            asm volatile("" : "+v"(dl), "+v"(thr));
            bool mlo[4], mhi[4];
#pragma unroll
            for (int e = 0; e < 4; ++e) { mlo[e] = (dl - e) <= 0; mhi[e] = (dl - e) >= 0; }
#pragma unroll
            for (int e = 0; e < 4; ++e) { s[0][0][e] = mlo[e] ? s[0][0][e] : NEG; s[8][0][e] = mhi[e] ? s[8][0][e] : NEG; s[1][1][e] = mlo[e] ? s[1][1][e] : NEG; s[9][1][e] = mhi[e] ? s[9][1][e] : NEG; }
            if (m64 < 2) {
#pragma unroll
                for (int kt = 0; kt < 10; ++kt)
#pragma unroll
                    for (int e = 0; e < 4; ++e) { const bool ok = (16 * kt + e) >= thr;
                        if (kt <= 8) s[kt][0][e] = ok ? s[kt][0][e] : NEG;
                        if (kt >= 1) s[kt][1][e] = ok ? s[kt][1][e] : NEG; }
            }
#pragma unroll
            for (int qt = 0; qt < 2; ++qt)
#pragma unroll
                for (int kt = qt; kt < qt + 9; ++kt)
#pragma unroll
                    for (int e = 0; e < 4; ++e) s[kt][qt][e] = __builtin_amdgcn_exp2f(s[kt][qt][e]);
            bf16x8 pf[5][2];
#pragma unroll
            for (int s5 = 0; s5 < 5; ++s5)
#pragma unroll
                for (int qt = 0; qt < 2; ++qt) { u32x4 w; w.x = pk2(s[2 * s5][qt][0], s[2 * s5][qt][1]); w.y = pk2(s[2 * s5][qt][2], s[2 * s5][qt][3]);
                    w.z = pk2(s[2 * s5 + 1][qt][0], s[2 * s5 + 1][qt][1]); w.w = pk2(s[2 * s5 + 1][qt][2], s[2 * s5 + 1][qt][3]); pf[s5][qt] = __builtin_bit_cast(bf16x8, w); }
            f32x4 o[8][2], ol[2];
#pragma unroll
            for (int dt = 0; dt < 8; ++dt) { o[dt][0] = (f32x4){0.f, 0.f, 0.f, 0.f}; o[dt][1] = (f32x4){0.f, 0.f, 0.f, 0.f}; }
            ol[0] = (f32x4){0.f, 0.f, 0.f, 0.f}; ol[1] = (f32x4){0.f, 0.f, 0.f, 0.f};
            const short ov = ((fr & 3) == 0) ? (short)0x3f80 : (short)0;
            const bf16x8 onesf = (bf16x8){ov, ov, ov, ov, ov, ov, ov, ov};
#pragma unroll
            for (int s5 = 0; s5 < 5; ++s5) {
                ol[0] = __builtin_amdgcn_mfma_f32_16x16x32_bf16(onesf, pf[s5][0], ol[0], 0, 0, 0);
                ol[1] = __builtin_amdgcn_mfma_f32_16x16x32_bf16(onesf, pf[s5][1], ol[1], 0, 0, 0);
                const int k0 = q0 + 32 * s5, sl = (m64 + 2 + (k0 >> 6)) & 3;
                const LAS unsigned char* vb = lds + sl * SLOT + VOFF + ((k0 & 63) + 4 * fq + (fr >> 2)) * VROW + 8 * (fr & 3);
#pragma unroll
                for (int dt = 0; dt < 8; ++dt) {
                    const s16x4 lo = __builtin_amdgcn_ds_read_tr16_b64_v4i16((LAS s16x4*)(vb + 32 * dt));
                    const s16x4 hi = __builtin_amdgcn_ds_read_tr16_b64_v4i16((LAS s16x4*)(vb + 32 * dt + 16 * VROW));
                    const bf16x8 vf = __builtin_shufflevector(lo, hi, 0, 1, 2, 3, 4, 5, 6, 7);
                    o[dt][0] = __builtin_amdgcn_mfma_f32_16x16x32_bf16(vf, pf[s5][0], o[dt][0], 0, 0, 0);
                    o[dt][1] = __builtin_amdgcn_mfma_f32_16x16x32_bf16(vf, pf[s5][1], o[dt][1], 0, 0, 0);
                }
            }
            const float lsum[2] = {fmaxf(ol[0][0], 1.0e-30f), fmaxf(ol[1][0], 1.0e-30f)};
            unsigned char* wsl = ws; asm volatile("" : "+s"(wsl));
            float* LSE = (float*)(wsl + WS_LSE); bf16_t* OM = (bf16_t*)(wsl + WS_OM); bf16_t* QOl = (bf16_t*)(wsl + WS_QO);
            if (g < 2) {
#pragma unroll
                for (int qt = 0; qt < 2; ++qt) {
                    const float inv = 1.0f / lsum[qt];
                    const size_t m = mb + ((size_t)(64 * m64 + q0 + 16 * qt + fr) << dsh);
                    bf16_t* op = qob + m * NQ + 4 * fq;
#pragma unroll
                    for (int dt = 0; dt < 8; ++dt) { u32x2 w; w.x = pk2(o[dt][qt][0] * inv, o[dt][qt][1] * inv); w.y = pk2(o[dt][qt][2] * inv, o[dt][qt][3] * inv); *(u32x2*)(op + 16 * dt) = w; }
                    if (fq == 0) LSE[m * 16 + g * 8 + hq] = (__builtin_amdgcn_logf(lsum[qt]) - nsh) * 0.69314718056f;
                }
            } else {
#pragma unroll
                for (int qt = 0; qt < 2; ++qt) { const size_t m = mb + ((size_t)(64 * m64 + q0 + 16 * qt + fr) << dsh);
                    const bf16_t* p0 = QOl + m * NQ + hq * 128 + 4 * fq;
                    u32x2 a0[8], a1[8];
#pragma unroll
                    for (int dt = 0; dt < 8; ++dt) { a0[dt] = *(const u32x2*)(p0 + 16 * dt); a1[dt] = *(const u32x2*)(p0 + 1024 + 16 * dt); }
                    const float l0 = LSE[m * 16 + hq], l1 = LSE[m * 16 + 8 + hq];
                    const float inv = 1.0f / lsum[qt], lse = (__builtin_amdgcn_logf(lsum[qt]) - nsh) * 0.69314718056f;
                    const float mw = fmaxf(lse, fmaxf(l0, l1));
                    float w0 = __expf(l0 - mw), w1 = __expf(l1 - mw), w2 = __expf(lse - mw); const float wi = 1.0f / (w0 + w1 + w2); w0 *= wi; w1 *= wi; w2 *= wi * inv;
                    bf16_t* op = OM + m * D + hq * 128 + 4 * fq;
#pragma unroll
                    for (int dt = 0; dt < 8; ++dt) { u32x2 w;
                        w.x = pk2(w0 * bf_lo(a0[dt].x) + w1 * bf_lo(a1[dt].x) + w2 * o[dt][qt][0], w0 * bf_hi(a0[dt].x) + w1 * bf_hi(a1[dt].x) + w2 * o[dt][qt][1]);
                        w.y = pk2(w0 * bf_lo(a0[dt].y) + w1 * bf_lo(a1[dt].y) + w2 * o[dt][qt][2], w0 * bf_hi(a0[dt].y) + w1 * bf_hi(a1[dt].y) + w2 * o[dt][qt][3]);
                        *(u32x2*)(op + 16 * dt) = w; }
                    asm volatile("" ::: "memory");
                }
            }
            if (i < 3) {
#pragma unroll
                for (int qt = 0; qt < 2; ++qt)
#pragma unroll
                    for (int ks = 0; ks < 4; ++ks) qf[qt][ks] = qn[qt][ks];
            }
            LDS_BARRIER();
        }
    }
    if (!synced) xcd_barrier(xbar);
}

#define XB_TMO      128
#define XB_XCNT(j)  (256  + 64 * (j))
#define XB_XSUB(j)  (1280 + 64 * (j))
#define XB_XGEN(j)  (2304 + 64 * (j))
#define XB_TOP      3328
#define XB_TOPGEN   3392
#define XCD_BAR_WORDS 3456
#define XB_SPIN_CAP (1u << 18)

__device__ __forceinline__ unsigned xb_ld(unsigned* p)              { return __hip_atomic_load(p, __ATOMIC_RELAXED, __HIP_MEMORY_SCOPE_AGENT); }
__device__ __forceinline__ unsigned xb_add(unsigned* p, unsigned v) { return __hip_atomic_fetch_add(p, v, __ATOMIC_RELAXED, __HIP_MEMORY_SCOPE_AGENT); }
__device__ __forceinline__ unsigned xb_xcc_id() { return (unsigned)__builtin_amdgcn_s_getreg((3 << 11) | 20) & 0xFu; }
#define XB_SPIN(cond, bar) do { unsigned _sp = 0; while (cond) { __builtin_amdgcn_s_sleep(1); \
    if ((++_sp & 255u) == 0u) { if (xb_ld(&(bar)[XB_TMO])) break; if (_sp > XB_SPIN_CAP) { atomicAdd(&(bar)[XB_TMO], 1u); break; } } } } while (0)

struct XcdBarrier {
    unsigned* bar; unsigned x;
    volatile LAS unsigned* st;
};

__device__ __forceinline__ XcdBarrier xcd_barrier_post(unsigned* bar, volatile LAS unsigned* st) {
    XcdBarrier b; b.bar = bar; b.x = xb_xcc_id(); b.st = st;
    if (threadIdx.x == 0) (void)xb_add(&bar[XB_XCNT(b.x)], 1u);
    return b;
}
__device__ __forceinline__ void xcd_barrier_complete(unsigned* bar, unsigned x, unsigned& nloc, unsigned& nx) {
    const unsigned G = gridDim.x * gridDim.y * gridDim.z;
    unsigned sum, cnt, mine, sp = 0u;
    for (;;) {
        sum = 0u; cnt = 0u; mine = 0u;
#pragma unroll
        for (unsigned j = 0; j < 16; ++j) { const unsigned c = xb_ld(&bar[XB_XCNT(j)]); sum += c; cnt += (c > 0u) ? 1u : 0u; mine = (j == x) ? c : mine; }
        if (sum == G) break;
        __builtin_amdgcn_s_sleep(1);
        if ((++sp & 255u) == 0u) { if (xb_ld(&bar[XB_TMO])) break; if (sp > XB_SPIN_CAP) { atomicAdd(&bar[XB_TMO], 1u); break; } }
    }
    nloc = mine > 0u ? mine : 1u; nx = cnt > 0u ? cnt : 1u;
}

__device__ __forceinline__ void xcd_barrier(const XcdBarrier& b) {
    asm volatile("s_waitcnt vmcnt(0)" ::: "memory");
    __syncthreads();
    if (threadIdx.x == 0) {
        unsigned* bar = b.bar;
        __builtin_amdgcn_s_waitcnt(0);
        unsigned nloc = b.st[0], nx = b.st[1];
        if (nloc == 0u) { xcd_barrier_complete(bar, b.x, nloc, nx); b.st[0] = nloc; b.st[1] = nx; }
        const unsigned old = xb_add(&bar[XB_XSUB(b.x)], 1u);
        const unsigned gen = old / nloc;
        if (old + 1u == (gen + 1u) * nloc) {
            __builtin_amdgcn_fence(__ATOMIC_RELEASE, "agent");
            asm volatile("s_waitcnt vmcnt(0)" ::: "memory");
            const unsigned og = xb_add(&bar[XB_TOP], 1u);
            const unsigned tg = og / nx;
            if (og + 1u == (tg + 1u) * nx) xb_add(&bar[XB_TOPGEN], 1u);
            else XB_SPIN(xb_ld(&bar[XB_TOPGEN]) == tg, bar);
            __builtin_amdgcn_fence(__ATOMIC_ACQUIRE, "agent");
            xb_add(&bar[XB_XGEN(b.x)], 1u);
            asm volatile("s_waitcnt vmcnt(0)" ::: "memory");
        } else {
            XB_SPIN(xb_ld(&bar[XB_XGEN(b.x)]) == gen, bar);
            __builtin_amdgcn_fence(__ATOMIC_ACQUIRE, "agent");
            asm volatile("s_waitcnt vmcnt(0)" ::: "memory");
        }
    }
    __syncthreads();
}

__global__ void __launch_bounds__(NTHR, 2) yoco_fwd(Params P) {
    extern __shared__ __attribute__((aligned(16))) unsigned char lds_raw[];
    LAS unsigned char* lds = (LAS unsigned char*)lds_raw;
    cg::grid_group grid = cg::this_grid();
    const int tid = threadIdx.x, lane = tid & 63, wave = __builtin_amdgcn_readfirstlane(tid >> 6);
    const int G = gridDim.x, bx = blockIdx.x, vcu = (G % 8 == 0) ? (bx % 8) * (G / 8) + bx / 8 : bx;
    unsigned char* ws = P.ws;
    float* rowss = (float*)(ws + WS_ROWSS);
    bf16_t* XA = (bf16_t*)(ws + WS_XA);
    typedef pg8::StaticOrder SO;
    volatile LAS unsigned* bst = (volatile LAS unsigned*)(lds + LDS_BYTES - 64);
    if (tid < 16) bst[tid] = 0u;
    __syncthreads();
    const XcdBarrier xbar = xcd_barrier_post((unsigned*)(ws + WS_BAR), bst);

    p0_prologue(P, lds, vcu, G, wave, lane);
    if (P.out == nullptr) grid.sync();
    xcd_barrier(xbar);
    { pg8::Gemm g{XA, (const bf16_t*)(ws + WS_W1), T, 2048, D}; SO S; S.init(T, 2048, G, bx);
      pg8::EpiRecIn E{(bf16_t*)(ws + WS_G), (bf16_t*)(ws + WS_XB)};
      pg8::gemm_phase<pg8::EpiRecIn, SO, true, true>(lds, g, S, E); }
    xcd_barrier(xbar);
    scan_phase(P, lds, vcu, G, tid, wave, lane);
    xcd_barrier(xbar);
    { pg8::Gemm g{(const bf16_t*)(ws + WS_YA), (const bf16_t*)(ws + WS_W2), T, D, D}; SO S; S.init(T, D, G, bx);
      pg8::EpiRes<true, false> E{P.in[0], XA, rowss};
      pg8::gemm_phase<pg8::EpiRes<true, false>, SO, true, true>(lds, g, S, E); }
    xcd_barrier(xbar);
    { pg8::Gemm g{XA, (const bf16_t*)(ws + WS_W3), T, 2 * FF, D}; SO S; S.init(T, 2 * FF, G, bx);
      pg8::EpiSwiGLU E{rowss, (bf16_t*)(ws + WS_ACT), FF};
      pg8::gemm_phase<pg8::EpiSwiGLU, SO, true, true>(lds, g, S, E); }
    xcd_barrier(xbar);
    { pg8::Gemm g{(const bf16_t*)(ws + WS_ACT), (const bf16_t*)(ws + WS_W4), T, D, FF}; SO S; S.init(T, D, G, bx);
      pg8::EpiRes<false, false> E{XA, XA, rowss + T};
      pg8::gemm_phase<pg8::EpiRes<false, false>, SO, true, true>(lds, g, S, E); }
    xcd_barrier(xbar);
    { pg8::Gemm g{XA, (const bf16_t*)(ws + WS_W5), T, NKVQ, D}; SO S; S.init(T, NKVQ, G, bx);
      pg8::EpiKVQ E{ws};
      pg8::gemm_phase<pg8::EpiKVQ, SO, true, true>(lds, g, S, E); }
    xcd_barrier(xbar);
    attn_phase(P, lds, vcu, G, tid, wave, lane, xbar);
    xcd_barrier(xbar);
    { pg8::Gemm g{(const bf16_t*)(ws + WS_OM), (const bf16_t*)(ws + WS_W6), T, D, D}; SO S; S.init(T, D, G, bx);
      pg8::EpiRes<false, false> E{XA, XA, rowss + 2 * T};
      pg8::gemm_phase<pg8::EpiRes<false, false>, SO, true, true>(lds, g, S, E); }
    xcd_barrier(xbar);
    { pg8::Gemm g{XA, (const bf16_t*)(ws + WS_W7), T, 2 * FF, D}; SO S; S.init(T, 2 * FF, G, bx);
      pg8::EpiSwiGLU E{rowss + 2 * T, (bf16_t*)(ws + WS_ACT), FF};
      pg8::gemm_phase<pg8::EpiSwiGLU, SO, true, true>(lds, g, S, E); }
    xcd_barrier(xbar);
    { pg8::Gemm g{(const bf16_t*)(ws + WS_ACT), (const bf16_t*)(ws + WS_W8), T, D, FF}; SO S; S.init(T, D, G, bx);
      pg8::EpiRes<false, true> E{XA, P.out, nullptr};
      pg8::gemm_phase<pg8::EpiRes<false, true>, SO, true, true>(lds, g, S, E); }
}

extern "C" void kernel_launch(void* const* d_in, const int* in_sizes, int n_in, void* d_out, int out_size, void* d_ws, size_t ws_size, hipStream_t stream) {
    static int grid = 0;
    if (grid == 0) {
        if (n_in != 25 || in_sizes[0] != T * D || out_size != T * D || ws_size < WS_END) { fprintf(stderr, "kernel_launch: unexpected shapes (n_in %d, in0 %d, out %d, ws %zu)\n", n_in, n_in > 0 ? in_sizes[0] : -1, out_size, ws_size); grid = -1; return; }
        int dev = 0, cus = 0, per_cu = 0;
        (void)hipGetDevice(&dev); (void)hipDeviceGetAttribute(&cus, hipDeviceAttributeMultiprocessorCount, dev);
        if (hipFuncSetAttribute((const void*)yoco_fwd, hipFuncAttributeMaxDynamicSharedMemorySize, LDS_BYTES) != hipSuccess) { fprintf(stderr, "kernel_launch: hipFuncSetAttribute failed\n"); grid = -1; return; }
        if (hipOccupancyMaxActiveBlocksPerMultiprocessor(&per_cu, (const void*)yoco_fwd, NTHR, LDS_BYTES) != hipSuccess || per_cu < 1) { fprintf(stderr, "kernel_launch: occupancy query says %d\n", per_cu); per_cu = 1; }
        (void)hipGetLastError();
        grid = cus * per_cu;
        if (grid % 8 != 0 || grid < 8) grid = cus;
    }
    if (grid < 0) return;
    if (hipMemsetAsync((char*)d_ws + WS_BAR, 0, 16384, stream) != hipSuccess) { fprintf(stderr, "kernel_launch: memset of barrier words failed\n"); return; }
    Params p{};
    for (int i = 0; i < 25; ++i) p.in[i] = (const float*)d_in[i];
    p.out = (float*)d_out; p.ws = (unsigned char*)d_ws;
    for (int i = 0; i < 16; ++i) p.invf[i] = std::pow(500000.0, -(double)i / 16.0);
    void* args[] = {&p};
    hipError_t e = hipLaunchCooperativeKernel((const void*)yoco_fwd, dim3(grid), dim3(NTHR), args, LDS_BYTES, stream);
    if (e != hipSuccess) fprintf(stderr, "kernel_launch: cooperative launch failed: %s (grid %d)\n", hipGetErrorString(e), grid);
}
```

```cpp
#include <hip/hip_runtime.h>
#include <hip/hip_cooperative_groups.h>
#include <cstdio>
#include <cstdint>
#include <cmath>
namespace cg = cooperative_groups;
namespace pg8 {
#define PG8_LAS __attribute__((address_space(3)))
typedef unsigned short bf16_t;
typedef short bf16x8 __attribute__((ext_vector_type(8)));
typedef float f32x4 __attribute__((ext_vector_type(4)));
typedef unsigned u32x4 __attribute__((ext_vector_type(4)));
constexpr int BM = 256, BK = 64, HALF = 128, HTB = HALF * BK * 2  , STAGE_BYTES = 8 * HTB, NXCD = 8, WGM = 8;

__host__ __device__ __forceinline__ int lds_byte(int r, int c) { const int st = (r >> 4) * 2 + (c >> 5), rr = r & 15, cc = c & 31, ob = rr * 64 + cc * 2; return st * 1024 + (ob ^ (((ob >> 9) & 1) << 5)); }
__host__ __device__ __forceinline__ void stage_rc(int b, int& R, int& C) { const int st = b / 1024, sb = b % 1024, swz = sb ^ (((sb >> 9) & 1) << 5); R = (st >> 1) * 16 + swz / 64; C = (st & 1) * 32 + (swz % 64) / 2; }
__host__ __device__ __forceinline__ int perm32(int rho) { const int n = rho >> 4, i = rho & 15; return 8 * (i >> 2) + 4 * n + (i & 3); }

struct Unit { int pm, pn; };
struct Gemm { const bf16_t* A; const bf16_t* Bt; int M, N, K; };

struct StaticOrder {
    int nM, nN, nwg, G, c, wgm;
    __host__ __device__ void init(int M, int N, int G_, int c_, int wgm_ = 1) { nM = M / BM; nN = N / BM; nwg = nM * nN; G = G_; c = c_; wgm = wgm_; }
    __host__ __device__ bool next(int i, Unit& u) const {
        const long L = (long)i * G + c; if (L >= nwg) return false;
        int wgid = (int)L; { const int q = nwg / NXCD, r = nwg % NXCD, xcd = wgid % NXCD, off = wgid / NXCD; wgid = (xcd < r ? xcd * (q + 1) : r * (q + 1) + (xcd - r) * q) + off; }
        const int nig = wgm * nN, gid = wgid / nig, fm = gid * wgm, gsz = (nM - fm) < wgm ? (nM - fm) : wgm;
        u.pm = fm + ((wgid % nig) % gsz); u.pn = (wgid % nig) / gsz; return true;
    }
    __device__ __forceinline__ void a_ready(const Unit&) const {}
    __device__ __forceinline__ void done(const Unit&) const {}
};

__device__ __forceinline__ unsigned cvt_pk_bf16(float lo, float hi) { unsigned r; asm volatile("v_cvt_pk_bf16_f32 %0, %1, %2" : "=v"(r) : "v"(lo), "v"(hi)); return r; }
typedef float f32x2 __attribute__((ext_vector_type(2)));

typedef unsigned u32x2 __attribute__((ext_vector_type(2)));
__device__ __forceinline__ float fast_sigmoid(float x) { return __builtin_amdgcn_rcpf(1.0f + __builtin_amdgcn_exp2f(-1.44269504089f * x)); }
__device__ __forceinline__ float gelu_tanh(float v) {
    const float t = v * (1.0f + 0.044715f * v * v);
    return v * __builtin_amdgcn_rcpf(1.0f + __builtin_amdgcn_exp2f(-2.302208198f * t));
}
__device__ __forceinline__ float ld_coherent(const float* p) { return __hip_atomic_load(p, __ATOMIC_RELAXED, __HIP_MEMORY_SCOPE_AGENT); }

struct EpiRecIn {
    static constexpr bool PERM = true, AFTER_DRAIN = false;
    bf16_t* Gt; bf16_t* XB;
    __device__ __forceinline__ void operator()(const f32x4 (&acc)[2][2][4][2], const Unit& u, int wr, int wc, int fr, int fq) const {
        const bool is_gate = u.pn < 4; bf16_t* base = is_gate ? Gt : XB;
        const int row0 = u.pm * BM + wr * 64 + fr, col0 = (u.pn & 3) * BM + wc * 32 + 8 * fq;
#pragma unroll
        for (int ai = 0; ai < 2; ++ai)
#pragma unroll
            for (int m = 0; m < 4; ++m) { bf16_t* rowp = base + (size_t)(row0 + ai * HALF + m * 16) * 1024 + col0;
#pragma unroll
                for (int bj = 0; bj < 2; ++bj) { f32x4 v0 = acc[ai][bj][m][0], v1 = acc[ai][bj][m][1];
                    if (is_gate) {
#pragma unroll
                        for (int e = 0; e < 4; ++e) { v0[e] = gelu_tanh(v0[e]); v1[e] = gelu_tanh(v1[e]); } }
                    u32x4 w; w.x = cvt_pk_bf16(v0[0], v0[1]); w.y = cvt_pk_bf16(v0[2], v0[3]); w.z = cvt_pk_bf16(v1[0], v1[1]); w.w = cvt_pk_bf16(v1[2], v1[3]);
                    *(u32x4*)(rowp + bj * HALF) = w; } }
    }
};
__device__ __forceinline__ float sum_fq(float v) {
    { const auto r = __builtin_amdgcn_permlane16_swap(__float_as_uint(v), __float_as_uint(v), false, false); v = __uint_as_float(r[0]) + __uint_as_float(r[1]); }
    { const auto r = __builtin_amdgcn_permlane32_swap(__float_as_uint(v), __float_as_uint(v), false, false); v = __uint_as_float(r[0]) + __uint_as_float(r[1]); }
    return v;
}
template <bool BASE_F32, bool OUT_F32> struct EpiRes {
    static constexpr bool PERM = true, AFTER_DRAIN = false;
    const void* base; void* out; float* rowss;
    __device__ __forceinline__ void finish(const f32x4 b0, const f32x4 b1, const f32x4 a0, const f32x4 a1, size_t off, float& ss) const {
        const f32x4 o0 = b0 + a0, o1 = b1 + a1;
        if (OUT_F32) { *(f32x4*)((float*)out + off) = o0; *(f32x4*)((float*)out + off + 4) = o1; }
        else { u32x4 w; w.x = cvt_pk_bf16(o0[0], o0[1]); w.y = cvt_pk_bf16(o0[2], o0[3]); w.z = cvt_pk_bf16(o1[0], o1[1]); w.w = cvt_pk_bf16(o1[2], o1[3]); *(u32x4*)((bf16_t*)out + off) = w; }
        ss += (o0[0] * o0[0] + o0[1] * o0[1]) + (o0[2] * o0[2] + o0[3] * o0[3]) + (o1[0] * o1[0] + o1[1] * o1[1]) + (o1[2] * o1[2] + o1[3] * o1[3]);
    }
    __device__ __forceinline__ void operator()(const f32x4 (&acc)[2][2][4][2], const Unit& u, int wr, int wc, int fr, int fq) const {
        asm volatile("" : "+v"(fr), "+v"(fq));
        const int row0 = u.pm * BM + wr * 64 + fr, col0 = u.pn * BM + wc * 32 + 8 * fq;
        if constexpr (!BASE_F32) {
            u32x4 bw[2][4][2];
#pragma unroll
            for (int ai = 0; ai < 2; ++ai)
#pragma unroll
                for (int m = 0; m < 4; ++m)
#pragma unroll
                    for (int bj = 0; bj < 2; ++bj) bw[ai][m][bj] = *(const u32x4*)((const bf16_t*)base + (size_t)(row0 + ai * HALF + m * 16) * 1024 + col0 + bj * HALF);
#pragma unroll
            for (int ai = 0; ai < 2; ++ai)
#pragma unroll
                for (int m = 0; m < 4; ++m) { const int r = row0 + ai * HALF + m * 16; const size_t off = (size_t)r * 1024 + col0; float ss = 0.f;
#pragma unroll
                    for (int bj = 0; bj < 2; ++bj) { const u32x4 w = bw[ai][m][bj];
                        const f32x4 b0 = (f32x4){__uint_as_float(w.x << 16), __uint_as_float(w.x & 0xffff0000u), __uint_as_float(w.y << 16), __uint_as_float(w.y & 0xffff0000u)};
                        const f32x4 b1 = (f32x4){__uint_as_float(w.z << 16), __uint_as_float(w.z & 0xffff0000u), __uint_as_float(w.w << 16), __uint_as_float(w.w & 0xffff0000u)};
                        finish(b0, b1, acc[ai][bj][m][0], acc[ai][bj][m][1], off + bj * HALF, ss); }
                    if (rowss) { ss = sum_fq(ss); if (fq == 0) __hip_atomic_fetch_add(rowss + r, ss, __ATOMIC_RELAXED, __HIP_MEMORY_SCOPE_AGENT); } }
        } else {
#pragma unroll
            for (int ai = 0; ai < 2; ++ai) {
                f32x4 bf[4][2][2];
#pragma unroll
                for (int m = 0; m < 4; ++m)
#pragma unroll
                    for (int bj = 0; bj < 2; ++bj) { const float* bp = (const float*)base + (size_t)(row0 + ai * HALF + m * 16) * 1024 + col0 + bj * HALF; bf[m][bj][0] = *(const f32x4*)bp; bf[m][bj][1] = *(const f32x4*)(bp + 4); }
#pragma unroll
                for (int m = 0; m < 4; ++m) { const int r = row0 + ai * HALF + m * 16; const size_t off = (size_t)r * 1024 + col0; float ss = 0.f;
#pragma unroll
                    for (int bj = 0; bj < 2; ++bj) finish(bf[m][bj][0], bf[m][bj][1], acc[ai][bj][m][0], acc[ai][bj][m][1], off + bj * HALF, ss);
                    if (rowss) { ss = sum_fq(ss); if (fq == 0) __hip_atomic_fetch_add(rowss + r, ss, __ATOMIC_RELAXED, __HIP_MEMORY_SCOPE_AGENT); } }
            }
        }
    }
};
struct EpiSwiGLU {
    static constexpr bool PERM = true, AFTER_DRAIN = false;
    const float* rowss; bf16_t* act; int ldo;
    __device__ __forceinline__ void operator()(const f32x4 (&acc)[2][2][4][2], const Unit& u, int wr, int wc, int fr, int fq) const {
        const int row0 = u.pm * BM + wr * 64 + fr, col0 = u.pn * HALF + wc * 32 + 8 * fq;
        float ssv[2][4];
#pragma unroll
        for (int ai = 0; ai < 2; ++ai)
#pragma unroll
            for (int m = 0; m < 4; ++m) ssv[ai][m] = ld_coherent(rowss + row0 + ai * HALF + m * 16);
#pragma unroll
        for (int ai = 0; ai < 2; ++ai)
#pragma unroll
            for (int m = 0; m < 4; ++m) { const int r = row0 + ai * HALF + m * 16;
                const float ss = ssv[ai][m] * (1.0f / 1024.0f) + 1e-6f, kk = -1.44269504089f * __builtin_amdgcn_rsqf(ss);
                float o[8];
#pragma unroll
                for (int n = 0; n < 2; ++n)
#pragma unroll
                    for (int e = 0; e < 4; ++e) { const float g = acc[ai][0][m][n][e], uu = acc[ai][1][m][n][e];
                        const float ex = __builtin_amdgcn_exp2f(g * kk); o[4 * n + e] = g * uu * __builtin_amdgcn_rcpf(ex * ss + ss); }
                u32x4 w; w.x = cvt_pk_bf16(o[0], o[1]); w.y = cvt_pk_bf16(o[2], o[3]); w.z = cvt_pk_bf16(o[4], o[5]); w.w = cvt_pk_bf16(o[6], o[7]);
                *(u32x4*)(act + (size_t)r * ldo + col0) = w; }
    }
};
struct EpiKVQ {
    static constexpr bool PERM = true, AFTER_DRAIN = false;
    unsigned char* ws;
    static constexpr size_t O_ROWSS = 64 * 1024 + (size_t)32768 * 4, O_GN = 768 * 1024 + 8192, O_ROPE = 1u << 20, O_KV = (size_t)128 << 20, O_Q = (size_t)224 << 20;
    __device__ __forceinline__ void operator()(const f32x4 (&acc)[2][2][4][2], const Unit& u, int wr, int wc, int fr, int fq) const {
        asm volatile("" : "+v"(fr), "+v"(fq));
        const float* rowss = (const float*)(ws + O_ROWSS); const float* cs = (const float*)(ws + O_ROPE); const float* sn = cs + (size_t)32768 * 16;
        PG8_LAS float* xl = (PG8_LAS float*)131072;
        const bool is_kv = u.pn < 6; bf16_t* base = (bf16_t*)(ws + (is_kv ? O_KV : O_Q)); const int ld = is_kv ? 1536 : 3072;
        const bool is_v = is_kv && (u.pn & 1); const int g = is_kv ? (u.pn >> 1) : ((u.pn - 6) >> 2);
        const int row0 = u.pm * BM + wr * 64 + fr, col0 = (is_kv ? u.pn : u.pn - 6) * BM + wc * 32 + 8 * fq;
        if (is_v) {
            float rv[2][4];
#pragma unroll
            for (int ai = 0; ai < 2; ++ai)
#pragma unroll
                for (int m = 0; m < 4; ++m) rv[ai][m] = ld_coherent(rowss + row0 + ai * HALF + m * 16);
#pragma unroll
            for (int ai = 0; ai < 2; ++ai)
#pragma unroll
                for (int m = 0; m < 4; ++m) { const int r = row0 + ai * HALF + m * 16;
                    const float rs = __builtin_amdgcn_rsqf(rv[ai][m] * (1.0f / 1024.0f) + 1e-6f);
                    bf16_t* rowp = base + (size_t)r * ld + col0;
#pragma unroll
                    for (int bj = 0; bj < 2; ++bj) { const f32x4 v0 = acc[ai][bj][m][0] * rs, v1 = acc[ai][bj][m][1] * rs;
                        u32x4 w; w.x = cvt_pk_bf16(v0[0], v0[1]); w.y = cvt_pk_bf16(v0[2], v0[3]); w.z = cvt_pk_bf16(v1[0], v1[1]); w.w = cvt_pk_bf16(v1[2], v1[3]);
                        *(u32x4*)(rowp + bj * HALF) = w; } }
            return;
        }
        f32x4 c0v[2][4], s0v[2][4];
#pragma unroll
        for (int ai = 0; ai < 2; ++ai)
#pragma unroll
            for (int m = 0; m < 4; ++m) { c0v[ai][m] = (f32x4){1.f, 1.f, 1.f, 1.f}; s0v[ai][m] = (f32x4){0.f, 0.f, 0.f, 0.f};
                if (fq == 0) { const size_t r_ = (size_t)(row0 + ai * HALF + m * 16); c0v[ai][m] = *(const f32x4*)(cs + r_ * 16 + 4 * wc); s0v[ai][m] = *(const f32x4*)(sn + r_ * 16 + 4 * wc); } }
        float rsv[2][4];
#pragma unroll
        for (int ai = 0; ai < 2; ++ai)
#pragma unroll
            for (int m = 0; m < 4; ++m) rsv[ai][m] = 1e-6f * (ld_coherent(rowss + row0 + ai * HALF + m * 16) * (1.0f / 1024.0f) + 1e-6f);
#pragma unroll
        for (int ai = 0; ai < 2; ++ai)
#pragma unroll
            for (int m = 0; m < 4; ++m)
#pragma unroll
                for (int bj = 0; bj < 2; ++bj) { const f32x4 a0 = acc[ai][bj][m][0], a1 = acc[ai][bj][m][1];
                    float ss = (a0[0] * a0[0] + a0[1] * a0[1]) + (a0[2] * a0[2] + a0[3] * a0[3]) + (a1[0] * a1[0] + a1[1] * a1[1]) + (a1[2] * a1[2] + a1[3] * a1[3]);
                    ss = sum_fq(ss);
                    if (fq == 0) xl[((ai * HALF + wr * 64 + m * 16 + fr) * 2 + bj) * 4 + wc] = ss; }
        asm volatile("s_waitcnt lgkmcnt(0)" ::: "memory"); __builtin_amdgcn_s_barrier(); asm volatile("" ::: "memory");
        const int d0 = (fq == 0) ? 4 * wc : 32 + 24 * wc + 8 * (fq - 1), d1 = (fq == 0) ? 16 + 4 * wc : d0 + 4;
        const float* gsrc = (const float*)(ws + O_GN) + (is_kv ? 0 : 384) + g * 128;
        const f32x4 gn0 = *(const f32x4*)(gsrc + d0), gn1 = *(const f32x4*)(gsrc + d1);
        const float qscale = is_kv ? 1.0f : 1.44269504089f * 0.08838834764831845f;
        const int tcol = (is_kv ? u.pn : u.pn - 6) * BM;
#pragma unroll
        for (int ai = 0; ai < 2; ++ai)
#pragma unroll
            for (int m = 0; m < 4; ++m) { const int rl = ai * HALF + wr * 64 + m * 16 + fr, r = u.pm * BM + rl;
                const float rs = rsv[ai][m];
                bf16_t* rowp = base + (size_t)r * ld + tcol;
                const f32x4 c0 = c0v[ai][m], s0 = s0v[ai][m];
#pragma unroll
                for (int bj = 0; bj < 2; ++bj) { const f32x4 pp = *(const PG8_LAS f32x4*)(xl + (rl * 2 + bj) * 4);
                    const float tot = (pp[0] + pp[1]) + (pp[2] + pp[3]);
                    const float f = __builtin_amdgcn_rsqf(tot * (1.0f / 128.0f) + rs) * qscale;
                    const f32x4 x1 = acc[ai][bj][m][0] * f * gn0, x2 = acc[ai][bj][m][1] * f * gn1;
                    if (fq == 0) { const f32x4 y1 = x1 * c0 - x2 * s0, y2 = x2 * c0 + x1 * s0;
                        u32x2 w1, w2; w1.x = cvt_pk_bf16(y1[0], y1[1]); w1.y = cvt_pk_bf16(y1[2], y1[3]); w2.x = cvt_pk_bf16(y2[0], y2[1]); w2.y = cvt_pk_bf16(y2[2], y2[3]);
                        *(u32x2*)(rowp + bj * HALF + d0) = w1; *(u32x2*)(rowp + bj * HALF + d1) = w2; }
                    else { u32x4 w; w.x = cvt_pk_bf16(x1[0], x1[1]); w.y = cvt_pk_bf16(x1[2], x1[3]); w.z = cvt_pk_bf16(x2[0], x2[1]); w.w = cvt_pk_bf16(x2[2], x2[3]);
                        *(u32x4*)(rowp + bj * HALF + d0) = w; } }
                }
    }
};

template <class Epi, class Sched, bool ALIGN_EPI = false, bool SP2 = false>
__device__ __forceinline__ void gemm_phase(PG8_LAS unsigned char* lds, const Gemm g, const Sched& S, const Epi& E) {
    int tid = threadIdx.x; asm volatile("" : "+v"(tid));
    const int wid = __builtin_amdgcn_readfirstlane(tid >> 6), lane = tid & 63, wr = wid >> 2, wc = wid & 3, fr = lane & 15, fq = lane >> 4;
    const int K = g.K, nt = K / BK;
    unsigned voffA[2], voffB[2];
#pragma unroll
    for (int i = 0; i < 2; ++i) { int R, C; stage_rc(tid * 16 + i * 8192, R, C); const int Rb = Epi::PERM ? ((R & ~31) + perm32(R & 31)) : R;
        voffA[i] = (unsigned)(R * K + C) * 2u; voffB[i] = (unsigned)(Rb * K + C) * 2u; }
    const size_t kstep = (size_t)(BK * 2);
    const size_t hstep = (size_t)HALF * K * 2;
    const size_t tstep = 2 * hstep;
    const unsigned ldsw = (unsigned)wid * 1024u;
    const int aoff = lds_byte(wr * 64 + fr, fq * 8), boff = lds_byte(wc * 32 + fr, fq * 8);
#define PG8_SA(b, h) (((b) * 2 + (h)) * HTB)
#define PG8_SB(b, h) ((4 + (b) * 2 + (h)) * HTB)
#define PG8_STAGE(bufoff, gbase, voff) do { _Pragma("unroll") for (int _i = 0; _i < 2; ++_i) \
        __builtin_amdgcn_global_load_lds((const unsigned*)((const char*)(gbase) + (voff)[_i]), (PG8_LAS unsigned*)(lds + (bufoff) + ldsw + _i * 8192), 16, 0, 0); } while (0)
#define PG8_LDA(dst, b, h) do { _Pragma("unroll") for (int m = 0; m < 4; ++m) _Pragma("unroll") for (int k = 0; k < 2; ++k) dst[m][k] = *(const PG8_LAS bf16x8*)(lds + PG8_SA(b, h) + aoff + m * 2048 + k * 1024); } while (0)
#define PG8_LDB(dst, b, h) do { _Pragma("unroll") for (int n = 0; n < 2; ++n) _Pragma("unroll") for (int k = 0; k < 2; ++k) dst[n][k] = *(const PG8_LAS bf16x8*)(lds + PG8_SB(b, h) + boff + n * 2048 + k * 1024); } while (0)
#define PG8_MMA(ai, bj, At, Bt) do { __builtin_amdgcn_s_setprio(1); _Pragma("unroll") for (int m = 0; m < 4; ++m) _Pragma("unroll") for (int n = 0; n < 2; ++n) _Pragma("unroll") for (int k = 0; k < 2; ++k) \
        acc[ai][bj][m][n] = __builtin_amdgcn_mfma_f32_16x16x32_bf16(Bt[n][k], At[m][k], acc[ai][bj][m][n], 0, 0, 0); __builtin_amdgcn_s_setprio(0); } while (0)
#define PG8_WAIT_V(n) asm volatile("s_waitcnt vmcnt(" #n ")" ::: "memory")
#define PG8_WAIT_L(n) asm volatile("s_waitcnt lgkmcnt(" #n ")" ::: "memory")
#define PG8_BAR __builtin_amdgcn_s_barrier()
#define PG8_SCHED __builtin_amdgcn_sched_barrier(0)
    Unit cur, nxt; int ui = 0;
    if (!S.next(0, cur)) return;
    f32x4 acc[2][2][4][2];
#pragma unroll
    for (int a = 0; a < 2; ++a)
#pragma unroll
        for (int b = 0; b < 2; ++b)
#pragma unroll
            for (int m = 0; m < 4; ++m)
#pragma unroll
                for (int n = 0; n < 2; ++n) acc[a][b][m][n] = (f32x4){0.f, 0.f, 0.f, 0.f};
    bf16x8 At[4][2], B0[2][2], B1[2][2];
    const char* cA = (const char*)g.A + (size_t)cur.pm * tstep; const char* cB = (const char*)g.Bt + (size_t)cur.pn * tstep;
    S.a_ready(cur);
    if constexpr (SP2) {
        PG8_STAGE(PG8_SB(0, 0), cB, voffB); PG8_STAGE(PG8_SB(0, 1), cB + hstep, voffB); PG8_STAGE(PG8_SA(0, 0), cA, voffA); PG8_STAGE(PG8_SA(0, 1), cA + hstep, voffA);
        if (wr == 1) PG8_BAR;
        PG8_WAIT_V(2); PG8_BAR;
        PG8_STAGE(PG8_SB(1, 0), cB + kstep, voffB); PG8_STAGE(PG8_SA(1, 0), cA + kstep, voffA); PG8_STAGE(PG8_SB(1, 1), cB + hstep + kstep, voffB);
        PG8_WAIT_V(6); PG8_BAR;
    } else {
        PG8_STAGE(PG8_SB(0, 0), cB, voffB); PG8_STAGE(PG8_SA(0, 0), cA, voffA); PG8_STAGE(PG8_SB(0, 1), cB + hstep, voffB); PG8_STAGE(PG8_SA(0, 1), cA + hstep, voffA);
        if (wr == 1) PG8_BAR;
        PG8_WAIT_V(4); PG8_BAR;
        PG8_STAGE(PG8_SB(1, 0), cB + kstep, voffB); PG8_STAGE(PG8_SA(1, 0), cA + kstep, voffA); PG8_STAGE(PG8_SB(1, 1), cB + hstep + kstep, voffB);
        PG8_WAIT_V(6); PG8_BAR;
    }
    for (;;) {
        const bool has_next = S.next(ui + 1, nxt);
        const char* nA = has_next ? (const char*)g.A + (size_t)nxt.pm * tstep : cA; const char* nB = has_next ? (const char*)g.Bt + (size_t)nxt.pn * tstep : cB;
        for (int t = 0; t < nt; t += 2) {
            const bool last = (t == nt - 2);
            const char* a1 = cA + (size_t)(t + 1) * kstep;
            const char* a2 = last ? nA : cA + (size_t)(t + 2) * kstep; const char* b2 = last ? nB : cB + (size_t)(t + 2) * kstep;
            const char* a3 = a2 + kstep; const char* b3 = b2 + kstep;
            if (last && has_next) S.a_ready(nxt);
            if constexpr (SP2) {
            PG8_LDB(B0, 0, 0); PG8_LDB(B1, 0, 1); PG8_SCHED; PG8_LDA(At, 0, 0); PG8_STAGE(PG8_SA(1, 1), a1 + hstep, voffA);
            PG8_WAIT_V(8); PG8_WAIT_L(0); PG8_BAR; PG8_MMA(0, 0, At, B0); PG8_MMA(0, 1, At, B1); PG8_BAR; PG8_SCHED;
            PG8_LDA(At, 0, 1); PG8_STAGE(PG8_SB(0, 0), b2, voffB); PG8_STAGE(PG8_SB(0, 1), b2 + hstep, voffB); PG8_STAGE(PG8_SA(0, 0), a2, voffA);
            PG8_WAIT_V(8); PG8_WAIT_L(0); PG8_BAR; PG8_MMA(1, 0, At, B0); PG8_MMA(1, 1, At, B1); PG8_BAR; PG8_SCHED;
            PG8_LDB(B0, 1, 0); PG8_LDB(B1, 1, 1); PG8_SCHED; PG8_LDA(At, 1, 0); PG8_STAGE(PG8_SA(0, 1), a2 + hstep, voffA);
            PG8_WAIT_V(8); PG8_WAIT_L(0); PG8_BAR; PG8_MMA(0, 0, At, B0); PG8_MMA(0, 1, At, B1); PG8_BAR; PG8_SCHED;
            PG8_LDA(At, 1, 1); PG8_STAGE(PG8_SB(1, 0), b3, voffB); PG8_STAGE(PG8_SB(1, 1), b3 + hstep, voffB); PG8_STAGE(PG8_SA(1, 0), a3, voffA);
            PG8_WAIT_V(8); PG8_WAIT_L(0); PG8_BAR; PG8_MMA(1, 0, At, B0); PG8_MMA(1, 1, At, B1); PG8_BAR; PG8_SCHED;
            } else {
            PG8_LDB(B0, 0, 0); PG8_SCHED; PG8_LDA(At, 0, 0); PG8_STAGE(PG8_SA(1, 1), a1 + hstep, voffA);
            PG8_WAIT_L(8); PG8_BAR; PG8_WAIT_L(0); PG8_MMA(0, 0, At, B0); PG8_BAR; PG8_SCHED;
            PG8_LDB(B1, 0, 1); PG8_STAGE(PG8_SB(0, 0), b2, voffB);
            PG8_BAR; PG8_WAIT_L(0); PG8_MMA(0, 1, At, B1); PG8_BAR;
            PG8_LDA(At, 0, 1); PG8_STAGE(PG8_SA(0, 0), a2, voffA);
            PG8_BAR; PG8_WAIT_L(0); PG8_MMA(1, 0, At, B0); PG8_BAR; PG8_SCHED;
            PG8_STAGE(PG8_SB(0, 1), b2 + hstep, voffB);
            PG8_WAIT_V(6); PG8_BAR; PG8_MMA(1, 1, At, B1); PG8_BAR;
            PG8_LDB(B0, 1, 0); PG8_SCHED; PG8_LDA(At, 1, 0); PG8_STAGE(PG8_SA(0, 1), a2 + hstep, voffA);
            PG8_WAIT_L(8); PG8_BAR; PG8_WAIT_L(0); PG8_MMA(0, 0, At, B0); PG8_BAR; PG8_SCHED;
            PG8_LDB(B1, 1, 1); PG8_STAGE(PG8_SB(1, 0), b3, voffB);
            PG8_BAR; PG8_WAIT_L(0); PG8_MMA(0, 1, At, B1); PG8_BAR;
            PG8_LDA(At, 1, 1); PG8_STAGE(PG8_SA(1, 0), a3, voffA);
            PG8_BAR; PG8_WAIT_L(0); PG8_MMA(1, 0, At, B0); PG8_BAR; PG8_SCHED;
            PG8_STAGE(PG8_SB(1, 1), b3 + hstep, voffB);
            PG8_WAIT_V(6); PG8_BAR; PG8_MMA(1, 1, At, B1); PG8_BAR;
            }
        }
        if constexpr (ALIGN_EPI) { if (wr == 0) PG8_BAR; }
        if constexpr (!Epi::AFTER_DRAIN) { E(acc, cur, wr, wc, fr, fq); S.done(cur); }
        if (!has_next) break;
#pragma unroll
        for (int a = 0; a < 2; ++a)
#pragma unroll
            for (int b = 0; b < 2; ++b)
#pragma unroll
                for (int m = 0; m < 4; ++m)
#pragma unroll
                    for (int n = 0; n < 2; ++n) acc[a][b][m][n] = (f32x4){0.f, 0.f, 0.f, 0.f};
        cur = nxt; cA = nA; cB = nB; ++ui;
        if constexpr (ALIGN_EPI) { if (wr == 1) PG8_BAR; }
    }
    PG8_WAIT_V(0);
    if constexpr (!ALIGN_EPI) { if (wr == 0) PG8_BAR; }
    PG8_BAR;
    if constexpr (Epi::AFTER_DRAIN) { E.fused(acc, cur, wr, wc, fr, fq, lds, wid, lane); S.done(cur); }
#undef PG8_SA
#undef PG8_SB
#undef PG8_STAGE
#undef PG8_LDA
#undef PG8_LDB
#undef PG8_MMA
#undef PG8_WAIT_V
#undef PG8_WAIT_L
#undef PG8_BAR
#undef PG8_SCHED
}
}

#define LAS __attribute__((address_space(3)))
typedef unsigned short bf16_t;
typedef short bf16x8 __attribute__((ext_vector_type(8)));
typedef short s16x4 __attribute__((ext_vector_type(4)));
typedef float f32x4 __attribute__((ext_vector_type(4)));
typedef float f32x2 __attribute__((ext_vector_type(2)));
typedef unsigned u32x4 __attribute__((ext_vector_type(4)));
typedef unsigned u32x2 __attribute__((ext_vector_type(2)));

constexpr int SEQ = 16384, NB = 2, T = NB * SEQ, D = 1024, FF = 2816, NKV = 1536, NQ = 3072, NKVQ = NKV + NQ;
constexpr int NWAVES = 8, NTHR = 512;
constexpr int LDS_BYTES = 148480;
constexpr float EPS = 1e-6f;

constexpr size_t MiB = 1u << 20;
constexpr size_t WS_BAR = 0;
constexpr size_t WS_ROWSS = 64 * 1024;
constexpr size_t WS_GN = 768 * 1024 + 8192;
constexpr size_t WS_SP = 768 * 1024;
constexpr size_t WS_ROPE = 1 * MiB;
constexpr size_t WS_AGG = 5 * MiB;
constexpr size_t WS_LSE = 7 * MiB;
constexpr size_t WS_GW = 10 * MiB;
constexpr size_t WS_W1 = 11 * MiB;
constexpr size_t WS_W2 = 15 * MiB;
constexpr size_t WS_W3 = 17 * MiB;
constexpr size_t WS_W4 = 28 * MiB;
constexpr size_t WS_W5 = 34 * MiB;
constexpr size_t WS_W6 = 43 * MiB;
constexpr size_t WS_W7 = 45 * MiB;
constexpr size_t WS_W8 = 56 * MiB;
constexpr size_t WS_PB = 62 * MiB;
constexpr size_t WS_XA = 64 * MiB;
constexpr size_t WS_G = 128 * MiB, WS_XB = 192 * MiB, WS_YA = 384 * MiB;
constexpr size_t WS_ACT = 128 * MiB;
constexpr size_t WS_KV = 128 * MiB, WS_QO = 224 * MiB, WS_OM = 416 * MiB;
constexpr size_t WS_END = 480 * MiB;
static_assert(pg8::EpiKVQ::O_ROWSS == WS_ROWSS + (size_t)T * 4 && pg8::EpiKVQ::O_GN == WS_GN && pg8::EpiKVQ::O_ROPE == WS_ROPE && pg8::EpiKVQ::O_KV == WS_KV && pg8::EpiKVQ::O_Q == WS_QO, "EpiKVQ offsets");

__device__ __forceinline__ float bf_lo(unsigned w) { return __uint_as_float(w << 16); }
__device__ __forceinline__ float bf_hi(unsigned w) { return __uint_as_float(w & 0xffff0000u); }
__device__ __forceinline__ unsigned pk2(float lo, float hi) { return pg8::cvt_pk_bf16(lo, hi); }
__device__ __forceinline__ float wave_sum(float v) {
#pragma unroll
    for (int o = 1; o < 64; o <<= 1) v += __shfl_xor(v, o);
    return v;
}
__device__ __forceinline__ float fsig(float x) { return __builtin_amdgcn_rcpf(1.0f + __builtin_amdgcn_exp2f(-1.44269504089f * x)); }

#define LDS_BARRIER() do { asm volatile("s_waitcnt lgkmcnt(0)" ::: "memory"); __builtin_amdgcn_s_barrier(); asm volatile("" ::: "memory"); } while (0)

struct Params {
    const float* in[25];
    float* out;
    unsigned char* ws;
    double invf[16];
};

__device__ __forceinline__ int hperm_row(int row) { const int d = row & 127; const int c = d < 32 ? 32 * ((d & 15) >> 2) + 4 * (d >> 4) + (d & 3) : 32 * ((d - 32) / 24) + 8 + ((d - 32) % 24); return (row & ~127) + c; }
__device__ __forceinline__ void wt_item(const float* W, int K, int N, bf16_t* WT, int dst_row0, const float* gain, LAS float* scr, int kb, int nb, int lane, bool hperm = false, float wscale = 1.0f) {
    const int k0 = 64 * kb, n0 = 32 * nb;
    { const int kk = lane >> 3, c4 = 4 * (lane & 7);
      f32x4 v[8];
#pragma unroll
      for (int i = 0; i < 8; ++i) v[i] = *(const f32x4*)(W + (size_t)(k0 + kk + 8 * i) * N + n0 + c4);
#pragma unroll
      for (int i = 0; i < 8; ++i) { const float gsc = gain ? gain[k0 + kk + 8 * i] : wscale; LAS float* d = scr + (kk + 8 * i) * 33 + c4;
          d[0] = v[i].x * gsc; d[1] = v[i].y * gsc; d[2] = v[i].z * gsc; d[3] = v[i].w * gsc; } }
    asm volatile("s_waitcnt lgkmcnt(0)" ::: "memory");
    const int c = lane & 7;
#pragma unroll
    for (int j = 0; j < 4; ++j) { const int n = (lane >> 3) + 8 * j; const LAS float* s = scr + (8 * c) * 33 + n;
        u32x4 o; o.x = pk2(s[0 * 33], s[1 * 33]); o.y = pk2(s[2 * 33], s[3 * 33]); o.z = pk2(s[4 * 33], s[5 * 33]); o.w = pk2(s[6 * 33], s[7 * 33]);
        const int drow = hperm ? hperm_row(dst_row0 + n) : dst_row0 + n;
        *(u32x4*)(WT + (size_t)drow * K + k0 + 8 * c) = o; }
    asm volatile("s_waitcnt lgkmcnt(0)" ::: "memory");
}

__device__ __forceinline__ void p0_prologue(const Params& P, LAS unsigned char* lds, int vcu, int G, int wave, int lane) {
    unsigned char* ws = P.ws;
    LAS float* scr = (LAS float*)(lds + wave * 16384);
    const int gw = vcu * NWAVES + wave, NGW = G * NWAVES;
    constexpr int C1 = (D / 64) * (2048 / 32), C2 = (D / 64) * (D / 32), C3 = (D / 64) * (2 * FF / 32), C4 = (FF / 64) * (D / 32), C5 = (D / 64) * (NKV / 32), C6 = (D / 64) * (NQ / 32), CG = 128;
    constexpr int NITEMS = C1 + C2 + C3 + C4 + C5 + C6 + C2 + C3 + C4 + CG;
    for (int it = gw; it < NITEMS; it += NGW) {
        int r = it;
        if (r < C1) { wt_item(P.in[3], D, 2048, (bf16_t*)(ws + WS_W1), (r % 64) * 32, nullptr, scr, r / 64, r % 64, lane); continue; } r -= C1;
        if (r < C2) { wt_item(P.in[11], D, D, (bf16_t*)(ws + WS_W2), (r % 32) * 32, nullptr, scr, r / 32, r % 32, lane); continue; } r -= C2;
        if (r < C3) { const int nb = r % 176, n0 = nb * 32, j = n0 < FF ? n0 : n0 - FF, dr = 256 * (j / 128) + (n0 < FF ? 0 : 128) + (j % 128);
            wt_item(P.in[13], D, 2 * FF, (bf16_t*)(ws + WS_W3), dr, P.in[12], scr, r / 176, nb, lane); continue; } r -= C3;
        if (r < C4) { wt_item(P.in[14], FF, D, (bf16_t*)(ws + WS_W4), (r % 32) * 32, nullptr, scr, r / 32, r % 32, lane); continue; } r -= C4;
        if (r < C5) { const int n0 = (r % 48) * 32; wt_item(P.in[16], D, NKV, (bf16_t*)(ws + WS_W5), n0, P.in[15], scr, r / 48, r % 48, lane, ((n0 >> 8) & 1) == 0); continue; } r -= C5;
        if (r < C6) { wt_item(P.in[19], D, NQ, (bf16_t*)(ws + WS_W5), NKV + (r % 96) * 32, P.in[18], scr, r / 96, r % 96, lane, true); continue; } r -= C6;
        if (r < C2) { wt_item(P.in[21], D, D, (bf16_t*)(ws + WS_W6), (r % 32) * 32, nullptr, scr, r / 32, r % 32, lane); continue; } r -= C2;
        if (r < C3) { const int nb = r % 176, n0 = nb * 32, j = n0 < FF ? n0 : n0 - FF, dr = 256 * (j / 128) + (n0 < FF ? 0 : 128) + (j % 128);
            wt_item(P.in[23], D, 2 * FF, (bf16_t*)(ws + WS_W7), dr, P.in[22], scr, r / 176, nb, lane); continue; } r -= C3;
        if (r < C4) { wt_item(P.in[24], FF, D, (bf16_t*)(ws + WS_W8), (r % 32) * 32, nullptr, scr, r / 32, r % 32, lane); continue; } r -= C4;
        { const int mat = r >> 3, which = mat >> 3, hh = mat & 7, rr = r & 7, kb = rr >> 2, nb = rr & 3;
          wt_item((which ? P.in[8] : P.in[6]) + hh * 16384, 128, 128, (bf16_t*)(ws + WS_GW) + hh * 256 * 128, which * 128 + nb * 32, nullptr, scr, kb, nb, lane, false, -1.44269504089f); }
    }
    {
        const float* x = P.in[0]; const float* gn = P.in[2]; bf16_t* XA = (bf16_t*)(ws + WS_XA);
        f32x4 gv[4];
#pragma unroll
        for (int j = 0; j < 4; ++j) gv[j] = *((const f32x4*)gn + lane + 64 * j);
        f32x4 v[2][4];
        if (2 * gw < T) { const f32x4* xr = (const f32x4*)(x + (size_t)(2 * gw) * D) + lane;
#pragma unroll
            for (int j = 0; j < 4; ++j) { v[0][j] = xr[64 * j]; v[1][j] = xr[256 + 64 * j]; } }
        for (int m = 2 * gw; m < T; m += 2 * NGW) {
            f32x4 vn[2][4]; const bool more = m + 2 * NGW < T;
            if (more) { const f32x4* xr = (const f32x4*)(x + (size_t)(m + 2 * NGW) * D) + lane;
#pragma unroll
                for (int j = 0; j < 4; ++j) { vn[0][j] = xr[64 * j]; vn[1][j] = xr[256 + 64 * j]; } }
            float s0 = 0.f, s1 = 0.f;
#pragma unroll
            for (int j = 0; j < 4; ++j) { s0 += (v[0][j].x * v[0][j].x + v[0][j].y * v[0][j].y) + (v[0][j].z * v[0][j].z + v[0][j].w * v[0][j].w);
                s1 += (v[1][j].x * v[1][j].x + v[1][j].y * v[1][j].y) + (v[1][j].z * v[1][j].z + v[1][j].w * v[1][j].w); }
            const float rs0 = 1.0f / sqrtf(wave_sum(s0) * (1.0f / D) + EPS), rs1 = 1.0f / sqrtf(wave_sum(s1) * (1.0f / D) + EPS);
            u32x2* o8 = (u32x2*)(XA + (size_t)m * D) + lane;
#pragma unroll
            for (int j = 0; j < 4; ++j) { u32x2 w; w.x = pk2(v[0][j].x * rs0 * gv[j].x, v[0][j].y * rs0 * gv[j].y); w.y = pk2(v[0][j].z * rs0 * gv[j].z, v[0][j].w * rs0 * gv[j].w); o8[64 * j] = w;
                u32x2 w2; w2.x = pk2(v[1][j].x * rs1 * gv[j].x, v[1][j].y * rs1 * gv[j].y); w2.y = pk2(v[1][j].z * rs1 * gv[j].z, v[1][j].w * rs1 * gv[j].w); o8[256 + 64 * j] = w2; }
            if (more) {
#pragma unroll
                for (int j = 0; j < 4; ++j) { v[0][j] = vn[0][j]; v[1][j] = vn[1][j]; } }
        }
    }
    const int gt = gw * 64 + lane, NGT = NGW * 64;
    { float* rowss = (float*)(ws + WS_ROWSS); for (int i = gt; i < 3 * T; i += NGT) rowss[i] = 0.f; }
    { u32x4* z0 = (u32x4*)(ws + WS_AGG); u32x4* z1 = (u32x4*)(ws + WS_PB); for (int i = gt; i < 131072; i += NGT) { z0[i] = (u32x4){0u, 0u, 0u, 0u}; z1[i] = (u32x4){0u, 0u, 0u, 0u}; } }
    { float* cs = (float*)(ws + WS_ROPE); float* sn = cs + (size_t)T * 16; const int* pos = (const int*)P.in[1];
      for (int i = gt; i < T * 16; i += NGT) { const int m = i >> 4, f = i & 15;
          const double rev = (double)pos[m] * P.invf[f] * 0.15915494309189535;
          const float fr = (float)(rev - __builtin_rint(rev));
          cs[i] = __builtin_amdgcn_cosf(fr); sn[i] = __builtin_amdgcn_sinf(fr); } }
    { float* gn = (float*)(ws + WS_GN); for (int i = gt; i < 768; i += NGT) gn[i] = i < 384 ? P.in[17][i] : P.in[20][i - 384]; }
    if (gt < 3) { float mk = 0.f, mq = 0.f; for (int i = 0; i < 128; ++i) { mk = fmaxf(mk, fabsf(P.in[17][gt * 128 + i])); mq = fmaxf(mq, fabsf(P.in[20][gt * 128 + i])); }
        ((float*)(ws + WS_GN))[768 + gt] = fminf(60.0f, 1.03f * 1.44269504089f * 11.3137085f * mk * mq); }
    { float* sp = (float*)(ws + WS_SP); const float* lam = P.in[10];
      for (int i = gt; i < 1024; i += NGT) { const float z = -lam[i]; sp[i] = 8.0f * (z > 15.f ? z : log1pf(__expf(z))); } }
}

__device__ __forceinline__ void scan_phase(const Params& P, LAS unsigned char* lds, int vcu, int G, int tid, int wave, int lane) {
    unsigned char* ws = P.ws;
    const bf16_t* XB = (const bf16_t*)(ws + WS_XB); const bf16_t* GW = (const bf16_t*)(ws + WS_GW);
    const float* conv_w = P.in[4]; const float* conv_b = P.in[5]; const float* ga_b = P.in[7]; const float* gx_b = P.in[9]; const float* SP = (const float*)(ws + WS_SP);
    unsigned long long* AH = (unsigned long long*)(ws + WS_AGG); unsigned long long* PP = (unsigned long long*)(ws + WS_PB);
    const bf16_t* Gt = (const bf16_t*)(ws + WS_G); bf16_t* YA = (bf16_t*)(ws + WS_YA);
    asm volatile("" : "+v"(tid), "+v"(lane));
    constexpr int AOFF = 0, BOFF = 128 * 272, LAOFF = 0, LUOFF = 128 * 132 * 4, SEGOFF = 2 * 128 * 132 * 4;
    const int fr = lane & 15, fq = lane >> 4, wm = wave >> 2, wn = wave & 3;
    const int blk0 = vcu & 7;
    const bf16_t* gwb = GW + (size_t)blk0 * 256 * 128 + (32 * wn + fr) * 128 + 8 * fq;
    const int c8 = tid & 15, tr = tid >> 4;
    u32x4 xw[7];
#define SCAN_LOAD_X(uu) do { const int ck_ = ((uu) >> 3) & 127, b_ = (uu) >> 10; const size_t mr_ = (size_t)(b_ * SEQ + ck_ * 128 + 4 * tr - 3); \
        _Pragma("unroll") for (int ri = 0; ri < 7; ++ri) { xw[ri] = (u32x4){0u, 0u, 0u, 0u}; if (ck_ * 128 + 4 * tr - 3 + ri >= 0) xw[ri] = *(const u32x4*)(XB + (mr_ + ri) * D + blk0 * 128 + 8 * c8); } } while (0)
    LAS float* CT = (LAS float*)(lds + 143360);
    for (int i = tid; i < 1024; i += NTHR) { float v;
        if (i < 512) v = conv_w[(i >> 7) * D + blk0 * 128 + (i & 127)]; else if (i < 640) v = conv_b[blk0 * 128 + (i - 512)]; else if (i < 768) v = SP[blk0 * 128 + (i - 640)] * -1.44269504089f;
        else if (i < 896) v = ga_b[blk0 * 128 + (i - 768)] * -1.44269504089f; else v = gx_b[blk0 * 128 + (i - 896)] * -1.44269504089f;
        CT[i] = v; }
    if (vcu < 2048) SCAN_LOAD_X(vcu);
    LDS_BARRIER();
    for (int u = vcu; u < 2048; u += G) {
        const int blk = blk0, ck = (u >> 3) & 127, b = u >> 10;
        const int m0 = b * SEQ + ck * 128, c0 = blk * 128;
        {
            const int ch = c0 + 8 * c8;
            float xr[7][8];
#pragma unroll
            for (int ri = 0; ri < 7; ++ri) { const u32x4 w = xw[ri];
                xr[ri][0] = bf_lo(w.x); xr[ri][1] = bf_hi(w.x); xr[ri][2] = bf_lo(w.y); xr[ri][3] = bf_hi(w.y); xr[ri][4] = bf_lo(w.z); xr[ri][5] = bf_hi(w.z); xr[ri][6] = bf_lo(w.w); xr[ri][7] = bf_hi(w.w); }
            float acc[4][8];
            { const f32x4 b0 = *(const LAS f32x4*)(CT + 512 + 8 * c8), b1 = *(const LAS f32x4*)(CT + 512 + 8 * c8 + 4);
#pragma unroll
              for (int j = 0; j < 4; ++j) { acc[j][0] = b0.x; acc[j][1] = b0.y; acc[j][2] = b0.z; acc[j][3] = b0.w; acc[j][4] = b1.x; acc[j][5] = b1.y; acc[j][6] = b1.z; acc[j][7] = b1.w; } }
#pragma unroll
            for (int k = 0; k < 4; ++k) { const f32x4 w0 = *(const LAS f32x4*)(CT + k * 128 + 8 * c8), w1 = *(const LAS f32x4*)(CT + k * 128 + 8 * c8 + 4);
                const float wk[8] = {w0.x, w0.y, w0.z, w0.w, w1.x, w1.y, w1.z, w1.w};
#pragma unroll
                for (int j = 0; j < 4; ++j)
#pragma unroll
                    for (int e = 0; e < 8; ++e) acc[j][e] += wk[e] * xr[j + k][e]; }
#pragma unroll
            for (int j = 0; j < 4; ++j) { u32x4 w; w.x = pk2(acc[j][0], acc[j][1]); w.y = pk2(acc[j][2], acc[j][3]); w.z = pk2(acc[j][4], acc[j][5]); w.w = pk2(acc[j][6], acc[j][7]);
                *(LAS u32x4*)(lds + AOFF + (4 * tr + j) * 272 + c8 * 16) = w; }
            if (u + G < 2048) SCAN_LOAD_X(u + G);
        }
        asm volatile("" ::: "memory");
        bf16x8 wrf[4][2], wif[4][2];
#pragma unroll
        for (int ks = 0; ks < 4; ++ks)
#pragma unroll
            for (int nt = 0; nt < 2; ++nt) { wrf[ks][nt] = *(const bf16x8*)(gwb + nt * 16 * 128 + 32 * ks); wif[ks][nt] = *(const bf16x8*)(gwb + (128 + nt * 16) * 128 + 32 * ks); }
        LDS_BARRIER();
        u32x4 gq[4];
#pragma unroll
        for (int j = 0; j < 4; ++j) gq[j] = *(const u32x4*)(Gt + (size_t)(m0 + 4 * tr + j) * D + c0 + 8 * c8);
        f32x4 ar[4][2], ai[4][2];
#pragma unroll
        for (int mt = 0; mt < 4; ++mt)
#pragma unroll
            for (int nt = 0; nt < 2; ++nt) { ar[mt][nt] = *(const LAS f32x4*)(CT + 768 + 32 * wn + 16 * nt + 4 * fq); ai[mt][nt] = *(const LAS f32x4*)(CT + 896 + 32 * wn + 16 * nt + 4 * fq); }
#pragma unroll
        for (int ks = 0; ks < 4; ++ks) {
            bf16x8 xf[4];
#pragma unroll
            for (int mt = 0; mt < 4; ++mt) xf[mt] = *(const LAS bf16x8*)(lds + AOFF + (64 * wm + 16 * mt + fr) * 272 + (32 * ks + 8 * fq) * 2);
#pragma unroll
            for (int mt = 0; mt < 4; ++mt)
#pragma unroll
                for (int nt = 0; nt < 2; ++nt) { ar[mt][nt] = __builtin_amdgcn_mfma_f32_16x16x32_bf16(wrf[ks][nt], xf[mt], ar[mt][nt], 0, 0, 0);
                    ai[mt][nt] = __builtin_amdgcn_mfma_f32_16x16x32_bf16(wif[ks][nt], xf[mt], ai[mt][nt], 0, 0, 0); }
        }
        u32x2 xcv[4][2];
#pragma unroll
        for (int mt = 0; mt < 4; ++mt)
#pragma unroll
            for (int nt = 0; nt < 2; ++nt) xcv[mt][nt] = *(const LAS u32x2*)(lds + AOFF + (64 * wm + 16 * mt + fr) * 272 + (32 * wn + 16 * nt + 4 * fq) * 2);
        LDS_BARRIER();
#pragma unroll
        for (int nt = 0; nt < 2; ++nt) {
            const int chl = 32 * wn + 16 * nt + 4 * fq;
            const f32x4 sp = *(const LAS f32x4*)(CT + 640 + chl);
#pragma unroll
            for (int mt = 0; mt < 4; ++mt) { const int tok = 64 * wm + 16 * mt + fr;
                const float xc[4] = {bf_lo(xcv[mt][nt].x), bf_hi(xcv[mt][nt].x), bf_lo(xcv[mt][nt].y), bf_hi(xcv[mt][nt].y)};
                f32x4 av, uv;
#pragma unroll
                for (int e = 0; e < 4; ++e) { const float rg = __builtin_amdgcn_rcpf(1.0f + __builtin_amdgcn_exp2f(ar[mt][nt][e])), ig = __builtin_amdgcn_rcpf(1.0f + __builtin_amdgcn_exp2f(ai[mt][nt][e]));
                    const float l2 = sp[e] * rg;
                    const float a = __builtin_amdgcn_exp2f(l2), a2 = a * a;
                    av[e] = a; uv[e] = __builtin_amdgcn_sqrtf(fmaxf(1.0f - a2, 0.f)) * ig * xc[e]; }
                *(LAS f32x4*)(lds + LAOFF + (tok * 132 + chl) * 4) = av; *(LAS f32x4*)(lds + LUOFF + (tok * 132 + chl) * 4) = uv; }
        }
        LDS_BARRIER();
        int t2 = tid; asm volatile("" : "+v"(t2));
        const int ch = t2 & 127, seg = __builtin_amdgcn_readfirstlane(t2 >> 7);
        LAS float* La = (LAS float*)(lds + LAOFF); LAS float* Lu = (LAS float*)(lds + LUOFF); LAS float* Sg = (LAS float*)(lds + SEGOFF);
        { float h = 0.f, A = 1.f;
#pragma unroll 8
          for (int j = 0; j < 32; ++j) { const int o = (32 * seg + j) * 132 + ch; const float a = La[o], uu = Lu[o]; h = a * h + uu; A *= a; La[o] = A; Lu[o] = h; }
          Sg[seg * 128 + ch] = A; Sg[512 + seg * 128 + ch] = h; }
        LDS_BARRIER();
        float cA = 1.f, cH = 0.f;
        for (int s2 = 0; s2 < seg; ++s2) { const float a = Sg[s2 * 128 + ch], hh = Sg[512 + s2 * 128 + ch]; cH = a * cH + hh; cA *= a; }
        const int ck0 = ck & ~31, nprev = ck - ck0;
        const size_t ao = (size_t)(b * 128 + ck) * 1024 + c0 + ch;
        float Atot = 0.f, Hend = 0.f;
        if (seg == 3) { const int o = 127 * 132 + ch; Atot = La[o] * cA; Hend = Lu[o] + La[o] * cH;
            __hip_atomic_store(AH + ao, ((unsigned long long)__float_as_uint(Hend) << 32) | (unsigned long long)(__float_as_uint(Atot) | 1u), __ATOMIC_RELAXED, __HIP_MEMORY_SCOPE_AGENT); }
        float C = 0.f;
        { const int q0 = 8 * seg, q1 = (q0 + 8 < nprev) ? q0 + 8 : nprev;
          const unsigned long long* ap = AH + (size_t)(b * 128 + ck0) * 1024 + c0 + ch;
          const unsigned long long* pq = PP + (size_t)(b * 128 + ck0 - 1) * 1024 + c0 + ch;
          unsigned long long av[8], pw = 1ull; unsigned spins = 0;
          for (;;) {
              bool ok = true;
#pragma unroll
              for (int q = 0; q < 8; ++q) { av[q] = 1ull; if (q0 + q < q1) av[q] = __hip_atomic_load(ap + (size_t)(q0 + q) * 1024, __ATOMIC_RELAXED, __HIP_MEMORY_SCOPE_AGENT); }
              if (ck0 > 0) pw = __hip_atomic_load(pq, __ATOMIC_RELAXED, __HIP_MEMORY_SCOPE_AGENT);
#pragma unroll
              for (int q = 0; q < 8; ++q) ok = ok && ((unsigned)av[q] != 0u);
              ok = ok && ((unsigned)pw != 0u);
              if (__all(ok)) break;
              __builtin_amdgcn_s_sleep(1);
              if (++spins > (1u << 18)) break;
          }
          float fA = 1.f, fH = 0.f;
#pragma unroll
          for (int q = 0; q < 8; ++q) if (q0 + q < q1) { const float a2 = __uint_as_float((unsigned)av[q]), h2 = __uint_as_float((unsigned)(av[q] >> 32)); fH = a2 * fH + h2; fA *= a2; }
          Sg[1024 + seg * 128 + ch] = fA; Sg[1536 + seg * 128 + ch] = fH;
          if (ck0 > 0) C = __uint_as_float((unsigned)(pw >> 32)); }
        LDS_BARRIER();
#pragma unroll
        for (int s2 = 0; s2 < 4; ++s2) C = Sg[1024 + s2 * 128 + ch] * C + Sg[1536 + s2 * 128 + ch];
        if (seg == 3) __hip_atomic_store(PP + ao, ((unsigned long long)__float_as_uint(Atot * C + Hend) << 32) | 0x3f800000ull, __ATOMIC_RELAXED, __HIP_MEMORY_SCOPE_AGENT);
        Sg[seg * 128 + ch] = cA * C + cH;
        LDS_BARRIER();
        const f32x4 cc0 = *(const LAS f32x4*)(Sg + (tr >> 3) * 128 + 8 * c8), cc1 = *(const LAS f32x4*)(Sg + (tr >> 3) * 128 + 8 * c8 + 4);
#pragma unroll
        for (int j = 0; j < 4; ++j) { const LAS float* hp = Lu + (4 * tr + j) * 132 + 8 * c8; const LAS float* ap = La + (4 * tr + j) * 132 + 8 * c8;
            const f32x4 h0 = *(const LAS f32x4*)hp + *(const LAS f32x4*)ap * cc0, h1 = *(const LAS f32x4*)(hp + 4) + *(const LAS f32x4*)(ap + 4) * cc1; const u32x4 g = gq[j];
            u32x4 w; w.x = pk2(bf_lo(g.x) * h0.x, bf_hi(g.x) * h0.y); w.y = pk2(bf_lo(g.y) * h0.z, bf_hi(g.y) * h0.w); w.z = pk2(bf_lo(g.z) * h1.x, bf_hi(g.z) * h1.y); w.w = pk2(bf_lo(g.w) * h1.z, bf_hi(g.w) * h1.w);
            *(u32x4*)(YA + (size_t)(m0 + 4 * tr + j) * D + c0 + 8 * c8) = w; }
        LDS_BARRIER();
    }
#undef SCAN_LOAD_X
}

struct XcdBarrier; __device__ __forceinline__ void xcd_barrier(const XcdBarrier& b);
__device__ __forceinline__ void attn_phase(const Params& P, LAS unsigned char* lds, int vcu, int G, int tid, int wave, int lane, const XcdBarrier& xbar) {
    unsigned char* ws = P.ws;
    asm volatile("" : "+v"(tid), "+v"(lane));
    const bf16_t* KV = (const bf16_t*)(ws + WS_KV); bf16_t* QO = (bf16_t*)(ws + WS_QO);
    constexpr int KROW = 272, VROW = 288, VOFF = 64 * KROW, SLOT = 64 * KROW + 64 * VROW;
    constexpr float NEG = -3.0e38f;
    const int fr = lane & 15, fq = lane >> 4;
    const int j = wave >> 1, q0 = 32 * (wave & 1);
    const int c16 = tid & 15, rr = tid >> 4;
    bool synced = false;
#pragma unroll 1
    for (int chain = vcu; chain < 768; chain += G) {
        const int g = chain >> 8, r8 = chain & 255, dsh = 2 * g;
        if (g == 2 && !synced) { xcd_barrier(xbar); synced = true; }

        const int cc = r8 & ((64 >> dsh) - 1), stream = r8 >> (6 - dsh), h = stream & 1, p = (stream >> 1) & ((1 << dsh) - 1), b = stream >> (1 + dsh);
        const size_t mb = (size_t)b * SEQ + p; const int hq = 4 * h + j, m0 = 4 * cc;
        const bf16_t* kvb = KV + g * 512 + h * 128 + 8 * c16;
        const float nsh = __uint_as_float((unsigned)__builtin_amdgcn_readfirstlane((int)__float_as_uint(-((const float*)(ws + WS_GN))[768 + g])));
        bf16_t* qob = QO + g * 1024 + hq * 128;
        bf16x8 qf[2][4];
#pragma unroll
        for (int qt = 0; qt < 2; ++qt) { const bf16_t* qp = qob + (mb + ((size_t)(64 * m0 + q0 + 16 * qt + fr) << dsh)) * NQ + 8 * fq;
#pragma unroll
            for (int ks = 0; ks < 4; ++ks) qf[qt][ks] = *(const bf16x8*)(qp + 32 * ks); }
        {
            u32x4 kw[6], vw[6];
#pragma unroll
            for (int t = 0; t < 3; ++t)
#pragma unroll
                for (int e = 0; e < 2; ++e) { const int tk = m0 - 2 + t, row = rr + 32 * e;
                    kw[2 * t + e] = (u32x4){0u, 0u, 0u, 0u}; vw[2 * t + e] = (u32x4){0u, 0u, 0u, 0u};
                    if (tk >= 0) { const bf16_t* kp = kvb + (mb + ((size_t)(64 * tk + row) << dsh)) * NKV; kw[2 * t + e] = *(const u32x4*)kp; vw[2 * t + e] = *(const u32x4*)(kp + 256); } }
#pragma unroll
            for (int t = 0; t < 3; ++t)
#pragma unroll
                for (int e = 0; e < 2; ++e) { const int sl = (m0 + 2 + t) & 3, row = rr + 32 * e;
                    *(LAS u32x4*)(lds + sl * SLOT + row * KROW + c16 * 16) = kw[2 * t + e]; *(LAS u32x4*)(lds + sl * SLOT + VOFF + row * VROW + c16 * 16) = vw[2 * t + e]; }
        }
        LDS_BARRIER();
#pragma unroll 1
        for (int i = 0; i < 4; ++i) {
            const int m64 = m0 + i;
            u32x4 kn[2], vn[2]; bf16x8 qn[2][4];
            if (i < 3) {
#pragma unroll
                for (int e = 0; e < 2; ++e) { const bf16_t* kp = kvb + (mb + ((size_t)(64 * (m64 + 1) + rr + 32 * e) << dsh)) * NKV; kn[e] = *(const u32x4*)kp; vn[e] = *(const u32x4*)(kp + 256); }
#pragma unroll
                for (int qt = 0; qt < 2; ++qt) { const bf16_t* qp = qob + (mb + ((size_t)(64 * (m64 + 1) + q0 + 16 * qt + fr) << dsh)) * NQ + 8 * fq;
#pragma unroll
                    for (int ks = 0; ks < 4; ++ks) qn[qt][ks] = *(const bf16x8*)(qp + 32 * ks); }
            }
            f32x4 s[10][2];
#pragma unroll
            for (int kt = 0; kt < 10; ++kt) { s[kt][0] = (kt <= 8) ? (f32x4){nsh, nsh, nsh, nsh} : (f32x4){0.f, 0.f, 0.f, 0.f}; s[kt][1] = (kt >= 1) ? (f32x4){nsh, nsh, nsh, nsh} : (f32x4){0.f, 0.f, 0.f, 0.f}; }
#pragma unroll
            for (int kt = 0; kt < 10; ++kt) {
                const int k0 = q0 + 16 * kt, sl = (m64 + 2 + (k0 >> 6)) & 3;
                const LAS unsigned char* kb = lds + sl * SLOT + ((k0 & 63) + fr) * KROW + 16 * fq;
#pragma unroll
                for (int ks = 0; ks < 4; ++ks) { const bf16x8 kf = *(const LAS bf16x8*)(kb + 64 * ks);
                    if (kt <= 8) s[kt][0] = __builtin_amdgcn_mfma_f32_16x16x32_bf16(kf, qf[0][ks], s[kt][0], 0, 0, 0);
                    if (kt >= 1) s[kt][1] = __builtin_amdgcn_mfma_f32_16x16x32_bf16(kf, qf[1][ks], s[kt][1], 0, 0, 0); }
            }
            if (i < 3) {
                const int sl = (m64 + 1) & 3;
#pragma unroll
                for (int e = 0; e < 2; ++e) { const int row = rr + 32 * e;
                    *(LAS u32x4*)(lds + sl * SLOT + row * KROW + c16 * 16) = kn[e]; *(LAS u32x4*)(lds + sl * SLOT + VOFF + row * VROW + c16 * 16) = vn[e]; }
            }
            int dl = fr - 4 * fq, thr = 128 - 64 * m64 - q0 - 4 * fq;
            asm volatile("" : "+v"(dl), "+v"(thr));
            bool mlo[4], mhi[4];
#pragma unroll
            for (int e = 0; e < 4; ++e) { mlo[e] = (dl - e) <= 0; mhi[e] = (dl - e) >= 0; }
#pragma unroll
            for (int e = 0; e < 4; ++e) { s[0][0][e] = mlo[e] ? s[0][0][e] : NEG; s[8][0][e] = mhi[e] ? s[8][0][e] : NEG; s[1][1][e] = mlo[e] ? s[1][1][e] : NEG; s[9][1][e] = mhi[e] ? s[9][1][e] : NEG; }
            if (m64 < 2) {
#pragma unroll
                for (int kt = 0; kt < 10; ++kt)
#pragma unroll
                    for (int e = 0; e < 4; ++e) { const bool ok = (16 * kt + e) >= thr;
                        if (kt <= 8) s[kt][0][e] = ok ? s[kt][0][e] : NEG;
                        if (kt >= 1) s[kt][1][e] = ok ? s[kt][1][e] : NEG; }
            }
#pragma unroll
            for (int qt = 0; qt < 2; ++qt)
#pragma unroll
                for (int kt = qt; kt < qt + 9; ++kt)
#pragma unroll
                    for (int e = 0; e < 4; ++e) s[kt][qt][e] = __builtin_amdgcn_exp2f(s[kt][qt][e]);
            bf16x8 pf[5][2];
#pragma unroll
            for (int s5 = 0; s5 < 5; ++s5)
#pragma unroll
                for (int qt = 0; qt < 2; ++qt) { u32x4 w; w.x = pk2(s[2 * s5][qt][0], s[2 * s5][qt][1]); w.y = pk2(s[2 * s5][qt][2], s[2 * s5][qt][3]);
                    w.z = pk2(s[2 * s5 + 1][qt][0], s[2 * s5 + 1][qt][1]); w.w = pk2(s[2 * s5 + 1][qt][2], s[2 * s5 + 1][qt][3]); pf[s5][qt] = __builtin_bit_cast(bf16x8, w); }
            f32x4 o[8][2], ol[2];
#pragma unroll
            for (int dt = 0; dt < 8; ++dt) { o[dt][0] = (f32x4){0.f, 0.f, 0.f, 0.f}; o[dt][1] = (f32x4){0.f, 0.f, 0.f, 0.f}; }
            ol[0] = (f32x4){0.f, 0.f, 0.f, 0.f}; ol[1] = (f32x4){0.f, 0.f, 0.f, 0.f};
            const short ov = ((fr & 3) == 0) ? (short)0x3f80 : (short)0;
            const bf16x8 onesf = (bf16x8){ov, ov, ov, ov, ov, ov, ov, ov};
#pragma unroll
            for (int s5 = 0; s5 < 5; ++s5) {
                ol[0] = __builtin_amdgcn_mfma_f32_16x16x32_bf16(onesf, pf[s5][0], ol[0], 0, 0, 0);
                ol[1] = __builtin_amdgcn_mfma_f32_16x16x32_bf16(onesf, pf[s5][1], ol[1], 0, 0, 0);
                const int k0 = q0 + 32 * s5, sl = (m64 + 2 + (k0 >> 6)) & 3;
                const LAS unsigned char* vb = lds + sl * SLOT + VOFF + ((k0 & 63) + 4 * fq + (fr >> 2)) * VROW + 8 * (fr & 3);
#pragma unroll
                for (int dt = 0; dt < 8; ++dt) {
                    const s16x4 lo = __builtin_amdgcn_ds_read_tr16_b64_v4i16((LAS s16x4*)(vb + 32 * dt));
                    const s16x4 hi = __builtin_amdgcn_ds_read_tr16_b64_v4i16((LAS s16x4*)(vb + 32 * dt + 16 * VROW));
                    const bf16x8 vf = __builtin_shufflevector(lo, hi, 0, 1, 2, 3, 4, 5, 6, 7);
                    o[dt][0] = __builtin_amdgcn_mfma_f32_16x16x32_bf16(vf, pf[s5][0], o[dt][0], 0, 0, 0);
                    o[dt][1] = __builtin_amdgcn_mfma_f32_16x16x32_bf16(vf, pf[s5][1], o[dt][1], 0, 0, 0);
                }
            }
            const float lsum[2] = {fmaxf(ol[0][0], 1.0e-30f), fmaxf(ol[1][0], 1.0e-30f)};
            unsigned char* wsl = ws; asm volatile("" : "+s"(wsl));
            float* LSE = (float*)(wsl + WS_LSE); bf16_t* OM = (bf16_t*)(wsl + WS_OM); bf16_t* QOl = (bf16_t*)(wsl + WS_QO);
            if (g < 2) {
#pragma unroll
                for (int qt = 0; qt < 2; ++qt) {
                    const float inv = 1.0f / lsum[qt];
                    const size_t m = mb + ((size_t)(64 * m64 + q0 + 16 * qt + fr) << dsh);
                    bf16_t* op = qob + m * NQ + 4 * fq;
#pragma unroll
                    for (int dt = 0; dt < 8; ++dt) { u32x2 w; w.x = pk2(o[dt][qt][0] * inv, o[dt][qt][1] * inv); w.y = pk2(o[dt][qt][2] * inv, o[dt][qt][3] * inv); *(u32x2*)(op + 16 * dt) = w; }
                    if (fq == 0) LSE[m * 16 + g * 8 + hq] = (__builtin_amdgcn_logf(lsum[qt]) - nsh) * 0.69314718056f;
                }
            } else {
#pragma unroll
                for (int qt = 0; qt < 2; ++qt) { const size_t m = mb + ((size_t)(64 * m64 + q0 + 16 * qt + fr) << dsh);
                    const bf16_t* p0 = QOl + m * NQ + hq * 128 + 4 * fq;
                    u32x2 a0[8], a1[8];
#pragma unroll
                    for (int dt = 0; dt < 8; ++dt) { a0[dt] = *(const u32x2*)(p0 + 16 * dt); a1[dt] = *(const u32x2*)(p0 + 1024 + 16 * dt); }
                    const float l0 = LSE[m * 16 + hq], l1 = LSE[m * 16 + 8 + hq];
                    const float inv = 1.0f / lsum[qt], lse = (__builtin_amdgcn_logf(lsum[qt]) - nsh) * 0.69314718056f;
                    const float mw = fmaxf(lse, fmaxf(l0, l1));
                    float w0 = __expf(l0 - mw), w1 = __expf(l1 - mw), w2 = __expf(lse - mw); const float wi = 1.0f / (w0 + w1 + w2); w0 *= wi; w1 *= wi; w2 *= wi * inv;
                    bf16_t* op = OM + m * D + hq * 128 + 4 * fq;
#pragma unroll
                    for (int dt = 0; dt < 8; ++dt) { u32x2 w;
                        w.x = pk2(w0 * bf_lo(a0[dt].x) + w1 * bf_lo(a1[dt].x) + w2 * o[dt][qt][0], w0 * bf_hi(a0[dt].x) + w1 * bf_hi(a1[dt].x) + w2 * o[dt][qt][1]);
                        w.y = pk2(w0 * bf_lo(a0[dt].y) + w1 * bf_lo(a1[dt].y) + w2 * o[dt][qt][2], w0 * bf_hi(a0[dt].y) + w1 * bf_hi(a1[dt].y) + w2 * o[dt][qt][3]);
                        *(u32x2*)(op + 16 * dt) = w; }
                    asm volatile("" ::: "memory");
                }
            }
            if (i < 3) {
#pragma unroll
                for (int qt = 0; qt < 2; ++qt)
#pragma unroll
                    for (int ks = 0; ks < 4; ++ks) qf[qt][ks] = qn[qt][ks];
            }
            LDS_BARRIER();
        }
    }
    if (!synced) xcd_barrier(xbar);
}

#define XB_TMO      128
#define XB_XCNT(j)  (256  + 64 * (j))
#define XB_XSUB(j)  (1280 + 64 * (j))
#define XB_XGEN(j)  (2304 + 64 * (j))
#define XB_TOP      3328
#define XB_TOPGEN   3392
#define XCD_BAR_WORDS 3456
#define XB_SPIN_CAP (1u << 18)

__device__ __forceinline__ unsigned xb_ld(unsigned* p)              { return __hip_atomic_load(p, __ATOMIC_RELAXED, __HIP_MEMORY_SCOPE_AGENT); }
__device__ __forceinline__ unsigned xb_add(unsigned* p, unsigned v) { return __hip_atomic_fetch_add(p, v, __ATOMIC_RELAXED, __HIP_MEMORY_SCOPE_AGENT); }
__device__ __forceinline__ unsigned xb_xcc_id() { return (unsigned)__builtin_amdgcn_s_getreg((3 << 11) | 20) & 0xFu; }
#define XB_SPIN(cond, bar) do { unsigned _sp = 0; while (cond) { __builtin_amdgcn_s_sleep(1); \
    if ((++_sp & 255u) == 0u) { if (xb_ld(&(bar)[XB_TMO])) break; if (_sp > XB_SPIN_CAP) { atomicAdd(&(bar)[XB_TMO], 1u); break; } } } } while (0)

struct XcdBarrier {
    unsigned* bar; unsigned x;
    volatile LAS unsigned* st;
};

__device__ __forceinline__ XcdBarrier xcd_barrier_post(unsigned* bar, volatile LAS unsigned* st) {
    XcdBarrier b; b.bar = bar; b.x = xb_xcc_id(); b.st = st;
    if (threadIdx.x == 0) (void)xb_add(&bar[XB_XCNT(b.x)], 1u);
    return b;
}
__device__ __forceinline__ void xcd_barrier_complete(unsigned* bar, unsigned x, unsigned& nloc, unsigned& nx) {
    const unsigned G = gridDim.x * gridDim.y * gridDim.z;
    unsigned sum, cnt, mine, sp = 0u;
    for (;;) {
        sum = 0u; cnt = 0u; mine = 0u;
#pragma unroll
        for (unsigned j = 0; j < 16; ++j) { const unsigned c = xb_ld(&bar[XB_XCNT(j)]); sum += c; cnt += (c > 0u) ? 1u : 0u; mine = (j == x) ? c : mine; }
        if (sum == G) break;
        __builtin_amdgcn_s_sleep(1);
        if ((++sp & 255u) == 0u) { if (xb_ld(&bar[XB_TMO])) break; if (sp > XB_SPIN_CAP) { atomicAdd(&bar[XB_TMO], 1u); break; } }
    }
    nloc = mine > 0u ? mine : 1u; nx = cnt > 0u ? cnt : 1u;
}

__device__ __forceinline__ void xcd_barrier(const XcdBarrier& b) {
    asm volatile("s_waitcnt vmcnt(0)" ::: "memory");
    __syncthreads();
    if (threadIdx.x == 0) {
        unsigned* bar = b.bar;
        __builtin_amdgcn_s_waitcnt(0);
        unsigned nloc = b.st[0], nx = b.st[1];
        if (nloc == 0u) { xcd_barrier_complete(bar, b.x, nloc, nx); b.st[0] = nloc; b.st[1] = nx; }
        const unsigned old = xb_add(&bar[XB_XSUB(b.x)], 1u);
        const unsigned gen = old / nloc;
        if (old + 1u == (gen + 1u) * nloc) {
            __builtin_amdgcn_fence(__ATOMIC_RELEASE, "agent");
            asm volatile("s_waitcnt vmcnt(0)" ::: "memory");
            const unsigned og = xb_add(&bar[XB_TOP], 1u);
            const unsigned tg = og / nx;
            if (og + 1u == (tg + 1u) * nx) xb_add(&bar[XB_TOPGEN], 1u);
            else XB_SPIN(xb_ld(&bar[XB_TOPGEN]) == tg, bar);
            __builtin_amdgcn_fence(__ATOMIC_ACQUIRE, "agent");
            xb_add(&bar[XB_XGEN(b.x)], 1u);
            asm volatile("s_waitcnt vmcnt(0)" ::: "memory");
        } else {
            XB_SPIN(xb_ld(&bar[XB_XGEN(b.x)]) == gen, bar);
            __builtin_amdgcn_fence(__ATOMIC_ACQUIRE, "agent");
            asm volatile("s_waitcnt vmcnt(0)" ::: "memory");
        }
    }
    __syncthreads();
}

__global__ void __launch_bounds__(NTHR, 2) yoco_fwd(Params P) {
    extern __shared__ __attribute__((aligned(16))) unsigned char lds_raw[];
    LAS unsigned char* lds = (LAS unsigned char*)lds_raw;
    cg::grid_group grid = cg::this_grid();
    const int tid = threadIdx.x, lane = tid & 63, wave = __builtin_amdgcn_readfirstlane(tid >> 6);
    const int G = gridDim.x, bx = blockIdx.x, vcu = (G % 8 == 0) ? (bx % 8) * (G / 8) + bx / 8 : bx;
    unsigned char* ws = P.ws;
    float* rowss = (float*)(ws + WS_ROWSS);
    bf16_t* XA = (bf16_t*)(ws + WS_XA);
    typedef pg8::StaticOrder SO;
    volatile LAS unsigned* bst = (volatile LAS unsigned*)(lds + LDS_BYTES - 64);
    if (tid < 16) bst[tid] = 0u;
    __syncthreads();
    const XcdBarrier xbar = xcd_barrier_post((unsigned*)(ws + WS_BAR), bst);

    p0_prologue(P, lds, vcu, G, wave, lane);
    if (P.out == nullptr) grid.sync();
    xcd_barrier(xbar);
    { pg8::Gemm g{XA, (const bf16_t*)(ws + WS_W1), T, 2048, D}; SO S; S.init(T, 2048, G, bx);
      pg8::EpiRecIn E{(bf16_t*)(ws + WS_G), (bf16_t*)(ws + WS_XB)};
      pg8::gemm_phase<pg8::EpiRecIn, SO, true, true>(lds, g, S, E); }
    xcd_barrier(xbar);
    scan_phase(P, lds, vcu, G, tid, wave, lane);
    xcd_barrier(xbar);
    { pg8::Gemm g{(const bf16_t*)(ws + WS_YA), (const bf16_t*)(ws + WS_W2), T, D, D}; SO S; S.init(T, D, G, bx);
      pg8::EpiRes<true, false> E{P.in[0], XA, rowss};
      pg8::gemm_phase<pg8::EpiRes<true, false>, SO, true, true>(lds, g, S, E); }
    xcd_barrier(xbar);
    { pg8::Gemm g{XA, (const bf16_t*)(ws + WS_W3), T, 2 * FF, D}; SO S; S.init(T, 2 * FF, G, bx);
      pg8::EpiSwiGLU E{rowss, (bf16_t*)(ws + WS_ACT), FF};
      pg8::gemm_phase<pg8::EpiSwiGLU, SO, true, true>(lds, g, S, E); }
    xcd_barrier(xbar);
    { pg8::Gemm g{(const bf16_t*)(ws + WS_ACT), (const bf16_t*)(ws + WS_W4), T, D, FF}; SO S; S.init(T, D, G, bx);
      pg8::EpiRes<false, false> E{XA, XA, rowss + T};
      pg8::gemm_phase<pg8::EpiRes<false, false>, SO, true, true>(lds, g, S, E); }
    xcd_barrier(xbar);
    { pg8::Gemm g{XA, (const bf16_t*)(ws + WS_W5), T, NKVQ, D}; SO S; S.init(T, NKVQ, G, bx);
      pg8::EpiKVQ E{ws};
      pg8::gemm_phase<pg8::EpiKVQ, SO, true, true>(lds, g, S, E); }
    xcd_barrier(xbar);
    attn_phase(P, lds, vcu, G, tid, wave, lane, xbar);
    xcd_barrier(xbar);
    { pg8::Gemm g{(const bf16_t*)(ws + WS_OM), (const bf16_t*)(ws + WS_W6), T, D, D}; SO S; S.init(T, D, G, bx);
      pg8::EpiRes<false, false> E{XA, XA, rowss + 2 * T};
      pg8::gemm_phase<pg8::EpiRes<false, false>, SO, true, true>(lds, g, S, E); }
    xcd_barrier(xbar);
    { pg8::Gemm g{XA, (const bf16_t*)(ws + WS_W7), T, 2 * FF, D}; SO S; S.init(T, 2 * FF, G, bx);
      pg8::EpiSwiGLU E{rowss + 2 * T, (bf16_t*)(ws + WS_ACT), FF};
      pg8::gemm_phase<pg8::EpiSwiGLU, SO, true, true>(lds, g, S, E); }
    xcd_barrier(xbar);
    { pg8::Gemm g{(const bf16_t*)(ws + WS_ACT), (const bf16_t*)(ws + WS_W8), T, D, FF}; SO S; S.init(T, D, G, bx);
      pg8::EpiRes<false, true> E{XA, P.out, nullptr};
      pg8::gemm_phase<pg8::EpiRes<false, true>, SO, true, true>(lds, g, S, E); }
}

extern "C" void kernel_launch(void* const* d_in, const int* in_sizes, int n_in, void* d_out, int out_size, void* d_ws, size_t ws_size, hipStream_t stream) {
    static int grid = 0;
    if (grid == 0) {
        if (n_in != 25 || in_sizes[0] != T * D || out_size != T * D || ws_size < WS_END) { fprintf(stderr, "kernel_launch: unexpected shapes (n_in %d, in0 %d, out %d, ws %zu)\n", n_in, n_in > 0 ? in_sizes[0] : -1, out_size, ws_size); grid = -1; return; }
        int dev = 0, cus = 0, per_cu = 0;
        (void)hipGetDevice(&dev); (void)hipDeviceGetAttribute(&cus, hipDeviceAttributeMultiprocessorCount, dev);
        if (hipFuncSetAttribute((const void*)yoco_fwd, hipFuncAttributeMaxDynamicSharedMemorySize, LDS_BYTES) != hipSuccess) { fprintf(stderr, "kernel_launch: hipFuncSetAttribute failed\n"); grid = -1; return; }
        if (hipOccupancyMaxActiveBlocksPerMultiprocessor(&per_cu, (const void*)yoco_fwd, NTHR, LDS_BYTES) != hipSuccess || per_cu < 1) { fprintf(stderr, "kernel_launch: occupancy query says %d\n", per_cu); per_cu = 1; }
        (void)hipGetLastError();
        grid = cus * per_cu;
        if (grid % 8 != 0 || grid < 8) grid = cus;
    }
    if (grid < 0) return;
    if (hipMemsetAsync((char*)d_ws + WS_BAR, 0, 16384, stream) != hipSuccess) { fprintf(stderr, "kernel_launch: memset of barrier words failed\n"); return; }
    Params p{};
    for (int i = 0; i < 25; ++i) p.in[i] = (const float*)d_in[i];
    p.out = (float*)d_out; p.ws = (unsigned char*)d_ws;
    for (int i = 0; i < 16; ++i) p.invf[i] = std::pow(500000.0, -(double)i / 16.0);
    void* args[] = {&p};
    hipError_t e = hipLaunchCooperativeKernel((const void*)yoco_fwd, dim3(grid), dim3(NTHR), args, LDS_BYTES, stream);
    if (e != hipSuccess) fprintf(stderr, "kernel_launch: cooperative launch failed: %s (grid %d)\n", hipGetErrorString(e), grid);
}
```
